# Optimizing an MI355X kernel written in HIP

```python
import math
import jax, jax.numpy as jnp
from jax import lax
import numpy as np

D_MODEL = 1024
BATCH = 16
SEQ = 256
DEPTH = 4
DEC_BATCH = 2
DEC_SEQ = 2048
PAST_LEN = 512

GRID_W = 64
N_MIXERS = 2
N_SSM_LAYERS = (DEPTH + 1) // 2
N_FOURIER_LAYERS = DEPTH // 2
S5_GROUP_CH = 16
S5_GROUPS = D_MODEL // S5_GROUP_CH
S5_STATE = 64
FOURIER_GROUPS = 4
FOURIER_GROUP_CH = D_MODEL // FOURIER_GROUPS
D_FF = 2816
CONV_W = 3
EPS = 1e-6
DT_MIN = 1e-3
DT_MAX = 1e-1

kernel_name = "s5_fnet_convffn_diffusion_step"


def rms_norm(x, g):
    xf = x.astype(jnp.float32)
    y = xf * lax.rsqrt(jnp.mean(xf * xf, axis=-1, keepdims=True) + EPS)
    return (y * g.astype(jnp.float32)).astype(x.dtype)


def _linear_recurrence(e1, e2):
    a1, b1 = e1
    a2, b2 = e2
    return a1 * a2, a2 * b1 + b2


def s5_direction(u, lam_re, lam_im, log_dt, b_re, b_im, c_re, c_im, h0, reverse):
    lam = lax.complex(lam_re.astype(jnp.float32), lam_im.astype(jnp.float32))
    dt = jnp.exp(log_dt.astype(jnp.float32))[:, None]
    abar = jnp.exp(lam * dt)
    bmat = lax.complex(b_re.astype(jnp.float32), b_im.astype(jnp.float32))
    bbar = ((abar - 1.0) / lam)[..., None] * bmat
    bu = jnp.einsum('blgc,gpc->blgp', u.astype(jnp.complex64), bbar)
    edge = -1 if reverse else 0
    bu = bu.at[:, edge].add(abar * h0)
    a = jnp.broadcast_to(abar, bu.shape)
    _, h = lax.associative_scan(_linear_recurrence, (a, bu), axis=1, reverse=reverse)
    cmat = lax.complex(c_re.astype(jnp.float32), c_im.astype(jnp.float32))
    y = jnp.real(jnp.einsum('gcp,blgp->blgc', cmat, h))
    return y, h[:, edge]


def s5_mixer(h, j, p, h0_re, h0_im):
    bsz, seq, dm = h.shape
    u = h.astype(jnp.float32).reshape(bsz, seq, S5_GROUPS, S5_GROUP_CH)
    y_sum = None
    fin_re, fin_im = [], []
    for d in range(2):
        h0 = lax.complex(h0_re[:, d].astype(jnp.float32), h0_im[:, d].astype(jnp.float32))
        y_d, fin = s5_direction(u, p['ssm_lam_re'][j, d], p['ssm_lam_im'][j, d], p['ssm_log_dt'][j, d],
                                p['ssm_b_re'][j, d], p['ssm_b_im'][j, d], p['ssm_c_re'][j, d], p['ssm_c_im'][j, d],
                                h0, reverse=(d == 1))
        y_sum = y_d if y_sum is None else y_sum + y_d
        fin_re.append(jnp.real(fin))
        fin_im.append(jnp.imag(fin))
    y = y_sum.reshape(bsz, seq, dm) + p['ssm_d'][j].astype(jnp.float32) * h.astype(jnp.float32)
    y = jax.nn.gelu(y).astype(h.dtype)
    z = y @ p['w_glu'][j] + p['b_glu'][j]
    out = z[..., :dm] * jax.nn.sigmoid(z[..., dm:])
    return out, jnp.stack(fin_re, axis=1), jnp.stack(fin_im, axis=1)


def fourier_mixer(h, j, p):
    bsz, seq, dm = h.shape
    hg = h.astype(jnp.float32).reshape(bsz, seq, FOURIER_GROUPS, FOURIER_GROUP_CH)
    f = jnp.real(jnp.fft.fft2(hg, axes=(1, 3), norm='ortho')).reshape(bsz, seq, dm).astype(h.dtype)
    return f @ p['w_fourier'][j] + p['b_fourier'][j]


def dwconv_rows(h, w, b, n_rows):
    bsz, seq, ch = h.shape
    hr = h.reshape(bsz, n_rows, seq // n_rows, ch)
    hp = jnp.pad(hr, ((0, 0), (0, 0), (1, 1), (0, 0)))
    out = w[0] * hp[:, :, :-2] + w[1] * hp[:, :, 1:-1] + w[2] * hp[:, :, 2:] + b
    return out.reshape(bsz, seq, ch)


def conv_ffn(h, i, p, n_rows):
    up = h @ p['w_up'][i]
    up = dwconv_rows(up, p['conv_w'][i], p['conv_b'][i], n_rows)
    gate, val = up[..., :D_FF], up[..., D_FF:]
    return (jax.nn.silu(gate) * val) @ p['w_down'][i]


def trunk(x, cond, h0_re, h0_im, n_rows, p, return_states):
    st_re, st_im = [], []
    for i in range(DEPTH):
        mod = (jax.nn.silu(cond) @ p['w_ada'][i] + p['b_ada'][i])[:, None, :]
        sh1, sc1, g1, sh2, sc2, g2 = jnp.split(mod, 6, axis=-1)
        h = rms_norm(x, p['g_mix'][i]) * (1.0 + sc1) + sh1
        j = i // N_MIXERS
        if i % N_MIXERS == 0:
            out, fr, fi = s5_mixer(h, j, p, h0_re[:, j], h0_im[:, j])
            if return_states:
                st_re.append(fr)
                st_im.append(fi)
        else:
            out = fourier_mixer(h, j, p)
        x = x + g1 * out
        h = rms_norm(x, p['g_ffn'][i]) * (1.0 + sc2) + sh2
        x = x + g2 * conv_ffn(h, i, p, n_rows)
    y = rms_norm(x, p['g_final'])
    if return_states:
        return y, jnp.stack(st_re, axis=1), jnp.stack(st_im, axis=1)
    return y


def setup_inputs(seed: int = 0) -> dict:
    key = jax.random.key(seed)
    ks = jax.random.split(key, 32)
    f32 = jnp.float32
    D = D_MODEL
    nrm = lambda k, shape, s: jax.random.normal(k, shape, f32) * s
    n_idx = jnp.arange(S5_STATE, dtype=f32)
    lam_re = -0.5 + nrm(ks[6], (N_SSM_LAYERS, 2, S5_GROUPS, S5_STATE), 0.01)
    lam_im = math.pi * n_idx + nrm(ks[7], (N_SSM_LAYERS, 2, S5_GROUPS, S5_STATE), 0.01)
    log_dt = jax.random.uniform(ks[8], (N_SSM_LAYERS, 2, S5_GROUPS), f32, math.log(DT_MIN), math.log(DT_MAX))
    bscale = (2.0 * S5_GROUP_CH) ** -0.5
    cscale = (2.0 * S5_STATE) ** -0.5
    return {
        'x_prompt': nrm(ks[0], (BATCH, SEQ, D), 1.0),
        'x_sample': nrm(ks[1], (DEC_BATCH, DEC_SEQ, D), 1.0),
        'state_ssm_re': nrm(ks[2], (DEC_BATCH, N_SSM_LAYERS, 2, S5_GROUPS, S5_STATE), 0.1),
        'state_ssm_im': nrm(ks[3], (DEC_BATCH, N_SSM_LAYERS, 2, S5_GROUPS, S5_STATE), 0.1),
        'c': nrm(ks[4], (DEC_BATCH, D), 1.0),
        'c_ctx': nrm(ks[5], (D,), 1.0),
        'w_ada': nrm(ks[9], (DEPTH, D, 6 * D), 0.5 * D ** -0.5),
        'b_ada': nrm(ks[10], (DEPTH, 6 * D), 0.01),
        'g_mix': 1.0 + nrm(ks[11], (DEPTH, D), 0.02),
        'g_ffn': 1.0 + nrm(ks[12], (DEPTH, D), 0.02),
        'ssm_lam_re': lam_re,
        'ssm_lam_im': lam_im,
        'ssm_log_dt': log_dt,
        'ssm_b_re': nrm(ks[13], (N_SSM_LAYERS, 2, S5_GROUPS, S5_STATE, S5_GROUP_CH), bscale),
        'ssm_b_im': nrm(ks[14], (N_SSM_LAYERS, 2, S5_GROUPS, S5_STATE, S5_GROUP_CH), bscale),
        'ssm_c_re': nrm(ks[15], (N_SSM_LAYERS, 2, S5_GROUPS, S5_GROUP_CH, S5_STATE), cscale),
        'ssm_c_im': nrm(ks[16], (N_SSM_LAYERS, 2, S5_GROUPS, S5_GROUP_CH, S5_STATE), cscale),
        'ssm_d': nrm(ks[17], (N_SSM_LAYERS, D), 1.0),
        'w_glu': nrm(ks[18], (N_SSM_LAYERS, D, 2 * D), D ** -0.5),
        'b_glu': nrm(ks[19], (N_SSM_LAYERS, 2 * D), 0.01),
        'w_fourier': nrm(ks[20], (N_FOURIER_LAYERS, D, D), D ** -0.5),
        'b_fourier': nrm(ks[21], (N_FOURIER_LAYERS, D), 0.01),
        'w_up': nrm(ks[22], (DEPTH, D, 2 * D_FF), D ** -0.5),
        'conv_w': nrm(ks[23], (DEPTH, CONV_W, 2 * D_FF), CONV_W ** -0.5),
        'conv_b': nrm(ks[24], (DEPTH, 2 * D_FF), 0.01),
        'w_down': nrm(ks[25], (DEPTH, D_FF, D), D_FF ** -0.5),
        'g_final': 1.0 + nrm(ks[26], (D,), 0.02),
    }


def reference(x_prompt, x_sample, state_ssm_re, state_ssm_im, c, c_ctx,
              w_ada, b_ada, g_mix, g_ffn,
              ssm_lam_re, ssm_lam_im, ssm_log_dt, ssm_b_re, ssm_b_im, ssm_c_re, ssm_c_im, ssm_d,
              w_glu, b_glu, w_fourier, b_fourier,
              w_up, conv_w, conv_b, w_down, g_final):
    p = {
        'w_ada': w_ada, 'b_ada': b_ada, 'g_mix': g_mix, 'g_ffn': g_ffn,
        'ssm_lam_re': ssm_lam_re, 'ssm_lam_im': ssm_lam_im, 'ssm_log_dt': ssm_log_dt,
        'ssm_b_re': ssm_b_re, 'ssm_b_im': ssm_b_im, 'ssm_c_re': ssm_c_re, 'ssm_c_im': ssm_c_im,
        'ssm_d': ssm_d, 'w_glu': w_glu, 'b_glu': b_glu,
        'w_fourier': w_fourier, 'b_fourier': b_fourier,
        'w_up': w_up, 'conv_w': conv_w, 'conv_b': conv_b, 'w_down': w_down, 'g_final': g_final,
    }
    bsz = x_prompt.shape[0]
    zeros = jnp.zeros((bsz, N_SSM_LAYERS, 2, S5_GROUPS, S5_STATE), jnp.float32)
    y_prompt, new_ssm_re, new_ssm_im = trunk(x_prompt, c_ctx[None, :], zeros, zeros, 1, p, True)
    rows = x_sample.shape[1] // GRID_W
    y_sample = trunk(x_sample, c, state_ssm_re, state_ssm_im, rows, p, False)
    return (y_prompt, y_sample, new_ssm_re, new_ssm_im)
```

```cpp
#include <hip/hip_runtime.h>
#include <hip/hip_cooperative_groups.h>
#include <cstdio>
#include <cstdint>
namespace cg = cooperative_groups;

#define LAS __attribute__((address_space(3)))
#define GAS __attribute__((address_space(1)))
typedef unsigned short bf16_t;
typedef short bf16x8 __attribute__((ext_vector_type(8)));
typedef float f32x4 __attribute__((ext_vector_type(4)));
typedef float f32x2 __attribute__((ext_vector_type(2)));
typedef float f32x16 __attribute__((ext_vector_type(16)));
typedef unsigned u32x4 __attribute__((ext_vector_type(4)));
typedef unsigned u32x2 __attribute__((ext_vector_type(2)));

constexpr int D = 1024, NTOK = 8192, DFF = 2816, NUP = 5632, DEPTH = 4;
constexpr int PPL = 7;
constexpr int NPHASE = 2 + PPL * DEPTH;
constexpr int NTHREADS = 512;

constexpr size_t MiB = 1u << 20;
constexpr size_t WS_MOD = 0;
constexpr size_t WS_BM = 1 * MiB;
constexpr size_t WS_CM = 2 * MiB;
constexpr size_t WS_AB = 3 * MiB;
constexpr size_t WS_A128 = 3 * MiB + 512 * 1024;
constexpr size_t WS_S = 4 * MiB;
constexpr size_t WS_DFTC = 8 * MiB;
constexpr size_t WS_AL256 = 9 * MiB;
constexpr size_t WS_AL2048 = 11 * MiB;
constexpr size_t WS_WGLU = 27 * MiB;
constexpr size_t WS_WF = 35 * MiB;
constexpr size_t WS_WUP = 39 * MiB;
constexpr size_t WS_WDN = 83 * MiB;
constexpr size_t WS_X = 105 * MiB;
constexpr size_t WS_H = 137 * MiB;
constexpr size_t WS_Y = 153 * MiB;
constexpr size_t WS_UP = 169 * MiB;
constexpr size_t WS_P = WS_UP;
constexpr size_t WS_ACT = 257 * MiB;
constexpr size_t WS_ZT = WS_ACT;
constexpr size_t WS_END = 301 * MiB;

constexpr int LDS_BYTES = 147456;

struct Params {
    const float *x_prompt, *x_sample, *st_re, *st_im, *c, *c_ctx;
    const float *w_ada, *b_ada, *g_mix, *g_ffn;
    const float *lam_re, *lam_im, *log_dt, *b_re, *b_im, *c_re, *c_im, *ssm_d;
    const float *w_glu, *b_glu, *w_fourier, *b_fourier, *w_up, *conv_w, *conv_b, *w_down, *g_final;
    float* out; unsigned char* ws;
    int ph_lo, ph_hi;
};

__device__ __forceinline__ unsigned cvt_pk_bf16(float lo, float hi) { unsigned r; asm("v_cvt_pk_bf16_f32 %0, %1, %2" : "=v"(r) : "v"(lo), "v"(hi)); return r; }
__device__ __forceinline__ float bf_lo(unsigned u) { return __uint_as_float(u << 16); }
__device__ __forceinline__ float bf_hi(unsigned u) { return __uint_as_float(u & 0xffff0000u); }
__device__ __forceinline__ float sigmoidf_(float t) { return __builtin_amdgcn_rcpf(1.0f + __expf(-t)); }
__device__ __forceinline__ float gelu_tanh(float v) { const float t = v * __builtin_fmaf(0.0713548162726f, v * v, 1.5957691216057308f); return v * sigmoidf_(t); }
__device__ __forceinline__ float wave_sum(float v, int lane) {
#pragma unroll
    for (int o = 1; o < 64; o <<= 1) v += __int_as_float(__builtin_amdgcn_ds_bpermute((lane ^ o) << 2, __float_as_int(v)));
    return v;
}
__device__ __forceinline__ int cond_of_row(int m) { return m < 4096 ? 0 : 1 + ((m - 4096) >> 11); }

namespace pg8 {
constexpr int BM = 256, BK = 64, HALF = 128, HTB = HALF * BK * 2, STAGE_BYTES = 8 * HTB, NXCD = 8, WGM = 8;
__host__ __device__ __forceinline__ int lds_byte(int r, int c) { const int st = (r >> 4) * 2 + (c >> 5), rr = r & 15, cc = c & 31, ob = rr * 64 + cc * 2; return st * 1024 + (ob ^ (((ob >> 9) & 1) << 5)); }
__host__ __device__ __forceinline__ void stage_rc(int b, int& R, int& C) { const int st = b / 1024, sb = b % 1024, swz = sb ^ (((sb >> 9) & 1) << 5); R = (st >> 1) * 16 + swz / 64; C = (st & 1) * 32 + (swz % 64) / 2; }
__host__ __device__ __forceinline__ int perm32(int rho) { const int n = rho >> 4, i = rho & 15; return 8 * (i >> 2) + 4 * n + (i & 3); }

struct Unit { int pm, pn, aux, nt, ks; const char* A; const char* B; };

__device__ __forceinline__ int xcd_remap(int L, int nwg) { const int q = nwg / NXCD, r = nwg % NXCD, xcd = L % NXCD, off = L / NXCD; return (xcd < r ? xcd * (q + 1) : r * (q + 1) + (xcd - r) * q) + off; }
__device__ __forceinline__ void tile_of(int wgid, int nM, int nN, int& pm, int& pn) { const int nig = WGM * nN, gid = wgid / nig, fm = gid * WGM, gsz = (nM - fm) < WGM ? (nM - fm) : WGM; pm = fm + ((wgid % nig) % gsz); pn = (wgid % nig) / gsz; }

template <class Epi, class Sched, bool ALIGN_EPI, bool SP2, bool HALFN = false>
__device__ __forceinline__ void gemm_phase(const int tid, LAS unsigned char* lds, const int lda, const int ldb, const Sched& S, const Epi& E) {
    const int wid = __builtin_amdgcn_readfirstlane(tid >> 6), lane = tid & 63, wr = wid >> 2, wc = wid & 3, fr = lane & 15, fq = lane >> 4;
    unsigned voffA[2], voffB[2];
#pragma unroll
    for (int i = 0; i < 2; ++i) { int R, C; stage_rc(tid * 16 + i * 8192, R, C); const int Rb = Epi::PERM ? ((R & ~31) + perm32(R & 31)) : R;
        voffA[i] = (unsigned)(R * lda + C) * 2u; voffB[i] = (unsigned)(Rb * ldb + C) * 2u; }
    const size_t kstep = (size_t)(BK * 2);
    const size_t hA = (size_t)HALF * lda * 2, hB = HALFN ? (size_t)0 : (size_t)HALF * ldb * 2;
    const unsigned ldsw = (unsigned)wid * 1024u;
    const int aoff = lds_byte(wr * 64 + fr, fq * 8), boff = lds_byte(wc * 32 + fr, fq * 8);
#define PG8_SA(b, h) (((b) * 2 + (h)) * HTB)
#define PG8_SB(b, h) ((4 + (b) * 2 + (h)) * HTB)
#define PG8_STAGE(bufoff, gbase, voff) do { _Pragma("unroll") for (int _i = 0; _i < 2; ++_i) \
        __builtin_amdgcn_global_load_lds((const unsigned*)((const char*)(gbase) + (voff)[_i]), (LAS unsigned*)(lds + (bufoff) + ldsw + _i * 8192), 16, 0, 0); } while (0)
#define PG8_LDA(dst, b, h) do { _Pragma("unroll") for (int m = 0; m < 4; ++m) _Pragma("unroll") for (int k = 0; k < 2; ++k) dst[m][k] = *(const LAS bf16x8*)(lds + PG8_SA(b, h) + aoff + m * 2048 + k * 1024); } while (0)
#define PG8_LDB(dst, b, h) do { _Pragma("unroll") for (int n = 0; n < 2; ++n) _Pragma("unroll") for (int k = 0; k < 2; ++k) dst[n][k] = *(const LAS bf16x8*)(lds + PG8_SB(b, h) + boff + n * 2048 + k * 1024); } while (0)
#define PG8_MMA(ai, bj, At, Bt) do { __builtin_amdgcn_s_setprio(1); _Pragma("unroll") for (int m = 0; m < 4; ++m) _Pragma("unroll") for (int n = 0; n < 2; ++n) _Pragma("unroll") for (int k = 0; k < 2; ++k) \
        acc[ai][bj][m][n] = __builtin_amdgcn_mfma_f32_16x16x32_bf16(Bt[n][k], At[m][k], acc[ai][bj][m][n], 0, 0, 0); __builtin_amdgcn_s_setprio(0); } while (0)
#define PG8_WAIT_V(n) asm volatile("s_waitcnt vmcnt(" #n ")" ::: "memory")
#define PG8_WAIT_L(n) asm volatile("s_waitcnt lgkmcnt(" #n ")" ::: "memory")
#define PG8_BAR __builtin_amdgcn_s_barrier()
#define PG8_SCHED __builtin_amdgcn_sched_barrier(0)
    Unit cur, nxt; int ui = 0;
    if (!S.next(0, cur)) return;
    f32x4 acc[2][2][4][2];
#pragma unroll
    for (int a = 0; a < 2; ++a)
#pragma unroll
        for (int b = 0; b < 2; ++b)
#pragma unroll
            for (int m = 0; m < 4; ++m)
#pragma unroll
                for (int n = 0; n < 2; ++n) acc[a][b][m][n] = (f32x4){0.f, 0.f, 0.f, 0.f};
    bf16x8 At[4][2], B0[2][2], B1[2][2];
    const char* cA = cur.A; const char* cB = cur.B;
    if constexpr (SP2) {
        PG8_STAGE(PG8_SB(0, 0), cB, voffB); PG8_STAGE(PG8_SB(0, 1), cB + hB, voffB); PG8_STAGE(PG8_SA(0, 0), cA, voffA); PG8_STAGE(PG8_SA(0, 1), cA + hA, voffA);
        if (wr == 1) PG8_BAR;
        PG8_WAIT_V(2); PG8_BAR;
        PG8_STAGE(PG8_SB(1, 0), cB + kstep, voffB); PG8_STAGE(PG8_SA(1, 0), cA + kstep, voffA); PG8_STAGE(PG8_SB(1, 1), cB + hB + kstep, voffB);
        PG8_WAIT_V(6); PG8_BAR;
    } else {
        PG8_STAGE(PG8_SB(0, 0), cB, voffB); PG8_STAGE(PG8_SA(0, 0), cA, voffA); PG8_STAGE(PG8_SB(0, 1), cB + hB, voffB); PG8_STAGE(PG8_SA(0, 1), cA + hA, voffA);
        if (wr == 1) PG8_BAR;
        PG8_WAIT_V(4); PG8_BAR;
        PG8_STAGE(PG8_SB(1, 0), cB + kstep, voffB); PG8_STAGE(PG8_SA(1, 0), cA + kstep, voffA); PG8_STAGE(PG8_SB(1, 1), cB + hB + kstep, voffB);
        PG8_WAIT_V(6); PG8_BAR;
    }
    for (;;) {
        const bool has_next = S.next(ui + 1, nxt);
        const char* nA = has_next ? nxt.A : cA; const char* nB = has_next ? nxt.B : cB;
        int nt = cur.nt; asm volatile("" : "+s"(nt));
#pragma nounroll
        for (int t = 0; t < nt; t += 2) {
            const bool last = (t == nt - 2);
            const char* a1 = cA + (size_t)(t + 1) * kstep;
            const char* a2 = last ? nA : cA + (size_t)(t + 2) * kstep; const char* b2 = last ? nB : cB + (size_t)(t + 2) * kstep;
            const char* a3 = a2 + kstep; const char* b3 = b2 + kstep;
            if constexpr (SP2) {
            PG8_LDB(B0, 0, 0); if constexpr (!HALFN) PG8_LDB(B1, 0, 1); PG8_SCHED; PG8_LDA(At, 0, 0); PG8_STAGE(PG8_SA(1, 1), a1 + hA, voffA);
            PG8_WAIT_V(8); PG8_WAIT_L(0); PG8_BAR; PG8_MMA(0, 0, At, B0); if constexpr (!HALFN) PG8_MMA(0, 1, At, B1); PG8_BAR; PG8_SCHED;
            PG8_LDA(At, 0, 1); PG8_STAGE(PG8_SB(0, 0), b2, voffB); PG8_STAGE(PG8_SB(0, 1), b2 + hB, voffB); PG8_STAGE(PG8_SA(0, 0), a2, voffA);
            PG8_WAIT_V(8); PG8_WAIT_L(0); PG8_BAR; PG8_MMA(1, 0, At, B0); if constexpr (!HALFN) PG8_MMA(1, 1, At, B1); PG8_BAR; PG8_SCHED;
            PG8_LDB(B0, 1, 0); if constexpr (!HALFN) PG8_LDB(B1, 1, 1); PG8_SCHED; PG8_LDA(At, 1, 0); PG8_STAGE(PG8_SA(0, 1), a2 + hA, voffA);
            PG8_WAIT_V(8); PG8_WAIT_L(0); PG8_BAR; PG8_MMA(0, 0, At, B0); if constexpr (!HALFN) PG8_MMA(0, 1, At, B1); PG8_BAR; PG8_SCHED;
            PG8_LDA(At, 1, 1); PG8_STAGE(PG8_SB(1, 0), b3, voffB); PG8_STAGE(PG8_SB(1, 1), b3 + hB, voffB); PG8_STAGE(PG8_SA(1, 0), a3, voffA);
            PG8_WAIT_V(8); PG8_WAIT_L(0); PG8_BAR; PG8_MMA(1, 0, At, B0); if constexpr (!HALFN) PG8_MMA(1, 1, At, B1); PG8_BAR; PG8_SCHED;
            } else {
            PG8_LDB(B0, 0, 0); PG8_SCHED; PG8_LDA(At, 0, 0); PG8_STAGE(PG8_SA(1, 1), a1 + hA, voffA);
            PG8_WAIT_L(8); PG8_BAR; PG8_WAIT_L(0); PG8_MMA(0, 0, At, B0); PG8_BAR; PG8_SCHED;
            PG8_LDB(B1, 0, 1); PG8_STAGE(PG8_SB(0, 0), b2, voffB);
            PG8_BAR; PG8_WAIT_L(0); PG8_MMA(0, 1, At, B1); PG8_BAR;
            PG8_LDA(At, 0, 1); PG8_STAGE(PG8_SA(0, 0), a2, voffA);
            PG8_BAR; PG8_WAIT_L(0); PG8_MMA(1, 0, At, B0); PG8_BAR; PG8_SCHED;
            PG8_STAGE(PG8_SB(0, 1), b2 + hB, voffB);
            PG8_WAIT_V(6); PG8_BAR; PG8_MMA(1, 1, At, B1); PG8_BAR;
            PG8_LDB(B0, 1, 0); PG8_SCHED; PG8_LDA(At, 1, 0); PG8_STAGE(PG8_SA(0, 1), a2 + hA, voffA);
            PG8_WAIT_L(8); PG8_BAR; PG8_WAIT_L(0); PG8_MMA(0, 0, At, B0); PG8_BAR; PG8_SCHED;
            PG8_LDB(B1, 1, 1); PG8_STAGE(PG8_SB(1, 0), b3, voffB);
            PG8_BAR; PG8_WAIT_L(0); PG8_MMA(0, 1, At, B1); PG8_BAR;
            PG8_LDA(At, 1, 1); PG8_STAGE(PG8_SA(1, 0), a3, voffA);
            PG8_BAR; PG8_WAIT_L(0); PG8_MMA(1, 0, At, B0); PG8_BAR; PG8_SCHED;
            PG8_STAGE(PG8_SB(1, 1), b3 + hB, voffB);
            PG8_WAIT_V(6); PG8_BAR; PG8_MMA(1, 1, At, B1); PG8_BAR;
            }
        }
        if constexpr (ALIGN_EPI) { if (wr == 0) PG8_BAR; }
        { int z = 0; asm volatile("" : "+v"(z)); const int ln = __builtin_amdgcn_mbcnt_hi(~0u, __builtin_amdgcn_mbcnt_lo(~0u, z));
          E(acc, cur, wr, wc, ln & 15, ln >> 4); }
        if (!has_next) break;
#pragma unroll
        for (int a = 0; a < 2; ++a)
#pragma unroll
            for (int b = 0; b < 2; ++b)
#pragma unroll
                for (int m = 0; m < 4; ++m)
#pragma unroll
                    for (int n = 0; n < 2; ++n) acc[a][b][m][n] = (f32x4){0.f, 0.f, 0.f, 0.f};
        cur = nxt; cA = nA; cB = nB; ++ui;
        if constexpr (ALIGN_EPI) { if (wr == 1) PG8_BAR; }
    }
    PG8_WAIT_V(0);
    if constexpr (!ALIGN_EPI) { if (wr == 0) PG8_BAR; }
    PG8_BAR;
#undef PG8_SA
#undef PG8_SB
#undef PG8_STAGE
#undef PG8_LDA
#undef PG8_LDB
#undef PG8_MMA
#undef PG8_WAIT_V
#undef PG8_WAIT_L
#undef PG8_BAR
#undef PG8_SCHED
}
}
using pg8::Unit;

struct SchedStd {
    const char* A; const char* B; int nM, nN, KS, lda, ldb, ntsplit, G, c, bn;
    __device__ __forceinline__ bool next(int i, Unit& u) const {
        const int nwg = nM * nN, tot = nwg * KS; const int L = i * G + c; if (L >= tot) return false;
        const int id = pg8::xcd_remap(L, tot); const int ks = KS - 1 - id / nwg, w = id % nwg; int pm, pn; pg8::tile_of(w, nM, nN, pm, pn);
        u.pm = pm; u.pn = pn; u.aux = ks; u.ks = ks; u.nt = ntsplit;
        u.A = A + ((size_t)pm * 256 * lda + (size_t)ks * ntsplit * 64) * 2; u.B = B + ((size_t)pn * bn * ldb + (size_t)ks * ntsplit * 64) * 2; return true;
    }
};
struct SchedChan {
    const char* dftc; const char* h; int G, c;
    __device__ __forceinline__ bool next(int i, Unit& u) const {
        const int L = i * G + c; if (L >= 256) return false;
        const int pm = L & 1, grp = (L >> 1) & 3, T = L >> 3;
        u.pm = pm; u.pn = T; u.aux = grp; u.nt = 4; u.ks = 0;
        u.A = dftc + (size_t)pm * 256 * 256 * 2; u.B = h + ((size_t)T * 256 * 1024 + grp * 256) * 2; return true;
    }
};
struct SchedSeq {
    const char* al256; const char* al2048; const char* zt; int G, c;
    __device__ __forceinline__ bool next(int i, Unit& u) const {
        const int L = i * G + c; if (L >= 320) return false;
        if (L < 256) { const int ksid = L >> 6, t = L & 63, ks = (ksid + 1) & 3;
            const int b = t >> 5, pm = (t >> 2) & 7, pn = t & 3;
            u.pm = t; u.pn = pn; u.aux = 4096 + b * 2048 + pm * 256; u.nt = 16; u.ks = ks;
            u.A = al2048 + ((size_t)pm * 256 * 4096 + ks * 1024) * 2; u.B = zt + ((size_t)2 * 1024 * 4096 + ((size_t)b * 1024 + pn * 256) * 4096 + ks * 1024) * 2; }
        else { const int l = L - 256, sq = l >> 2, pn = l & 3;
            u.pm = 0; u.pn = pn; u.aux = sq * 256; u.nt = 8; u.ks = -1;
            u.A = al256; u.B = zt + (((size_t)(sq >> 3) * 1024 + pn * 256) * 4096 + (sq & 7) * 512) * 2; }
        return true;
    }
};

struct SchedSeqH {
    const char* al256; const char* al2048; const char* zt; int G, c;
    __device__ __forceinline__ bool next(int i, Unit& u) const {
        const int L = i * G + c; if (L >= 256) return false;
        if (L < 128) { const int b = L >> 6, pm = (L >> 3) & 7, pn = L & 7;
            u.pm = pm; u.pn = pn; u.aux = 4096 + b * 2048 + pm * 256; u.nt = 64; u.ks = 0;
            u.A = al2048 + (size_t)pm * 256 * 4096 * 2; u.B = zt + ((size_t)2 * 1024 * 4096 + ((size_t)b * 1024 + pn * 128) * 4096) * 2; }
        else { const int l = L - 128, sq = l >> 3, pn = l & 7;
            u.pm = 0; u.pn = pn; u.aux = sq * 256; u.nt = 8; u.ks = 0;
            u.A = al256; u.B = zt + (((size_t)(sq >> 3) * 1024 + pn * 128) * 4096 + (sq & 7) * 512) * 2; }
        return true;
    }
};

struct EpiGlu {
    static constexpr bool PERM = false;
    float* x; const float* bias; const float* mod_g;
    __device__ __forceinline__ void operator()(const f32x4 (&acc)[2][2][4][2], const Unit& u, int wr, int wc, int fr, int fq) const {
        const int cv = u.pm < 16 ? 0 : 1 + ((u.pm - 16) >> 3);
        const int ch0 = u.pn * 128 + wc * 32 + 4 * fq;
        f32x4 b1[2], b2[2], gg[2];
#pragma unroll
        for (int n = 0; n < 2; ++n) { b1[n] = *(const f32x4*)(bias + ch0 + 16 * n); b2[n] = *(const f32x4*)(bias + 1024 + ch0 + 16 * n); gg[n] = *(const f32x4*)(mod_g + cv * 6144 + ch0 + 16 * n); }
#pragma unroll
        for (int ai = 0; ai < 2; ++ai)
#pragma unroll
            for (int m = 0; m < 4; ++m) { float* rowp = x + (size_t)(u.pm * 256 + ai * 128 + wr * 64 + m * 16 + fr) * D + ch0;
#pragma unroll
                for (int n = 0; n < 2; ++n) { const f32x4 z1 = acc[ai][0][m][n] + b1[n], z2 = acc[ai][1][m][n] + b2[n]; f32x4 xv = *(const f32x4*)(rowp + 16 * n);
#pragma unroll
                    for (int q = 0; q < 4; ++q) xv[q] += gg[n][q] * (z1[q] * sigmoidf_(z2[q]));
                    *(f32x4*)(rowp + 16 * n) = xv; } }
    }
};
typedef unsigned long long u64_t;
__device__ __forceinline__ void st_wt16(bf16_t* p, int fq, u32x4 w) {
    GAS u64_t* q = (GAS u64_t*)(p - 8 * fq) + fq;
    __hip_atomic_store(q, (u64_t)w.x | ((u64_t)w.y << 32), __ATOMIC_RELAXED, __HIP_MEMORY_SCOPE_AGENT);
    __hip_atomic_store(q + 4, (u64_t)w.z | ((u64_t)w.w << 32), __ATOMIC_RELAXED, __HIP_MEMORY_SCOPE_AGENT);
}
__device__ __forceinline__ u32x4 ld_ag16(const bf16_t* p, int fq) {
    const GAS u64_t* q = (const GAS u64_t*)(p - 8 * fq) + fq;
    const u64_t a = __hip_atomic_load(q, __ATOMIC_RELAXED, __HIP_MEMORY_SCOPE_AGENT), b = __hip_atomic_load(q + 4, __ATOMIC_RELAXED, __HIP_MEMORY_SCOPE_AGENT);
    return (u32x4){(unsigned)a, (unsigned)(a >> 32), (unsigned)b, (unsigned)(b >> 32)};
}
__device__ __forceinline__ void handoff_publish(unsigned* flag, bool lane0) {
    asm volatile("s_waitcnt vmcnt(0)" ::: "memory");
    if (lane0) (void)__hip_atomic_fetch_add(flag, 1u, __ATOMIC_RELAXED, __HIP_MEMORY_SCOPE_AGENT);
}
__device__ __forceinline__ void handoff_wait(unsigned* flag, unsigned want) {
    unsigned spins = 0;
    while (__hip_atomic_load(flag, __ATOMIC_RELAXED, __HIP_MEMORY_SCOPE_AGENT) < want) { __builtin_amdgcn_s_sleep(2); if (++spins > (1u << 22)) break; }
    asm volatile("" ::: "memory");
}
struct EpiPartial {
    static constexpr bool PERM = true;
    bf16_t* P;
    __device__ __forceinline__ void operator()(const f32x4 (&acc)[2][2][4][2], const Unit& u, int wr, int wc, int fr, int fq) const {
        bf16_t* base = P + (size_t)u.aux * NTOK * D + (size_t)(u.pm * 256 + wr * 64 + fr) * D + u.pn * 256 + wc * 32 + 8 * fq;
#pragma unroll
        for (int ai = 0; ai < 2; ++ai)
#pragma unroll
            for (int m = 0; m < 4; ++m) { bf16_t* rowp = base + (size_t)(ai * 128 + m * 16) * D;
#pragma unroll
                for (int bj = 0; bj < 2; ++bj) { const f32x4 v0 = acc[ai][bj][m][0], v1 = acc[ai][bj][m][1]; u32x4 w;
                    w.x = cvt_pk_bf16(v0[0], v0[1]); w.y = cvt_pk_bf16(v0[2], v0[3]); w.z = cvt_pk_bf16(v1[0], v1[1]); w.w = cvt_pk_bf16(v1[2], v1[3]);
                    *(u32x4*)(rowp + bj * 128) = w; } }
    }
};
struct EpiResidH {
    static constexpr bool PERM = false;
    float* x; const float* gvec; const float* bias;
    __device__ __forceinline__ void operator()(const f32x4 (&acc)[2][2][4][2], const Unit& u, int wr, int wc, int fr, int fq) const {
        const int cv = u.pm < 16 ? 0 : 1 + ((u.pm - 16) >> 3);
        const int col0 = u.pn * 128 + wc * 32 + 4 * fq;
        f32x4 g[2], b[2];
#pragma unroll
        for (int n = 0; n < 2; ++n) { g[n] = *(const f32x4*)(gvec + cv * 6144 + col0 + 16 * n); b[n] = bias ? *(const f32x4*)(bias + col0 + 16 * n) : (f32x4){0.f, 0.f, 0.f, 0.f}; }
#pragma unroll
        for (int ai = 0; ai < 2; ++ai)
#pragma unroll
            for (int m = 0; m < 4; ++m) { float* rowp = x + (size_t)(u.pm * 256 + ai * 128 + wr * 64 + m * 16 + fr) * D + col0;
#pragma unroll
                for (int n = 0; n < 2; ++n) { f32x4 xv = *(const f32x4*)(rowp + 16 * n); xv += g[n] * (acc[ai][0][m][n] + b[n]); *(f32x4*)(rowp + 16 * n) = xv; } }
    }
};
struct EpiSeqH {
    static constexpr bool PERM = true;
    bf16_t* f;
    __device__ __forceinline__ void operator()(const f32x4 (&acc)[2][2][4][2], const Unit& u, int wr, int wc, int fr, int fq) const {
        bf16_t* base = f + (size_t)(u.aux + wr * 64 + fr) * D + u.pn * 128 + wc * 32 + 8 * fq;
#pragma unroll
        for (int ai = 0; ai < 2; ++ai)
#pragma unroll
            for (int m = 0; m < 4; ++m) { const f32x4 v0 = acc[ai][0][m][0], v1 = acc[ai][0][m][1]; u32x4 w;
                w.x = cvt_pk_bf16(v0[0], v0[1]); w.y = cvt_pk_bf16(v0[2], v0[3]); w.z = cvt_pk_bf16(v1[0], v1[1]); w.w = cvt_pk_bf16(v1[2], v1[3]);
                *(u32x4*)(base + (size_t)(ai * 128 + m * 16) * D) = w; }
    }
};
struct EpiResid {
    static constexpr bool PERM = true;
    float* x; bf16_t* P; const float* gvec; const float* bias; unsigned* flags;
    __device__ __forceinline__ void operator()(const f32x4 (&acc)[2][2][4][2], const Unit& u, int wr, int wc, int fr, int fq) const {
        unsigned* flag = flags + (u.pm * 4 + u.pn) * 16;
        const size_t off = (size_t)(u.pm * 256 + wr * 64 + fr) * D + u.pn * 256 + wc * 32 + 8 * fq;
        if (u.ks == 1) {
#pragma unroll
            for (int ai = 0; ai < 2; ++ai)
#pragma unroll
                for (int m = 0; m < 4; ++m) { bf16_t* rowp = P + off + (size_t)(ai * 128 + m * 16) * D;
#pragma unroll
                    for (int bj = 0; bj < 2; ++bj) { const f32x4 v0 = acc[ai][bj][m][0], v1 = acc[ai][bj][m][1]; u32x4 w;
                        w.x = cvt_pk_bf16(v0[0], v0[1]); w.y = cvt_pk_bf16(v0[2], v0[3]); w.z = cvt_pk_bf16(v1[0], v1[1]); w.w = cvt_pk_bf16(v1[2], v1[3]);
                        st_wt16(rowp + bj * 128, fq, w); } }
            handoff_publish(flag, fr == 0 && fq == 0);
        } else {
            handoff_wait(flag, 8u);
            const int cv = u.pm < 16 ? 0 : 1 + ((u.pm - 16) >> 3);
            const int col0 = u.pn * 256 + wc * 32 + 8 * fq;
#pragma unroll
            for (int bj = 0; bj < 2; ++bj) {
                const f32x4 g0 = *(const f32x4*)(gvec + cv * 6144 + col0 + bj * 128), g1 = *(const f32x4*)(gvec + cv * 6144 + col0 + bj * 128 + 4);
                f32x4 b0 = {0.f, 0.f, 0.f, 0.f}, b1 = b0;
                if (bias) { b0 = *(const f32x4*)(bias + col0 + bj * 128); b1 = *(const f32x4*)(bias + col0 + bj * 128 + 4); }
#pragma unroll
                for (int ai = 0; ai < 2; ++ai)
#pragma unroll
                    for (int m = 0; m < 4; ++m) { const size_t o = off + (size_t)(ai * 128 + m * 16) * D + bj * 128;
                        const u32x4 pw = ld_ag16(P + o, fq); f32x4 x0 = *(const f32x4*)(x + o), x1 = *(const f32x4*)(x + o + 4);
                        const f32x4 p0 = {bf_lo(pw.x), bf_hi(pw.x), bf_lo(pw.y), bf_hi(pw.y)}, p1 = {bf_lo(pw.z), bf_hi(pw.z), bf_lo(pw.w), bf_hi(pw.w)};
                        x0 += g0 * (acc[ai][bj][m][0] + p0 + b0); x1 += g1 * (acc[ai][bj][m][1] + p1 + b1);
                        *(f32x4*)(x + o) = x0; *(f32x4*)(x + o + 4) = x1; }
            }
        }
    }
};
struct EpiUpRaw {
    static constexpr bool PERM = true;
    bf16_t* out;
    __device__ __forceinline__ void operator()(const f32x4 (&acc)[2][2][4][2], const Unit& u, int wr, int wc, int fr, int fq) const {
        bf16_t* base = out + (size_t)(u.pm * 256 + wr * 64 + fr) * NUP + u.pn * 256 + wc * 32 + 8 * fq;
#pragma unroll
        for (int ai = 0; ai < 2; ++ai)
#pragma unroll
            for (int m = 0; m < 4; ++m) { bf16_t* rowp = base + (size_t)(ai * 128 + m * 16) * NUP;
#pragma unroll
                for (int bj = 0; bj < 2; ++bj) { const f32x4 v0 = acc[ai][bj][m][0], v1 = acc[ai][bj][m][1]; u32x4 w;
                    w.x = cvt_pk_bf16(v0[0], v0[1]); w.y = cvt_pk_bf16(v0[2], v0[3]); w.z = cvt_pk_bf16(v1[0], v1[1]); w.w = cvt_pk_bf16(v1[2], v1[3]);
                    *(u32x4*)(rowp + bj * 128) = w; } }
    }
};
struct EpiChan {
    static constexpr bool PERM = true;
    bf16_t* zt;
    __device__ __forceinline__ void operator()(const f32x4 (&acc)[2][2][4][2], const Unit& u, int wr, int wc, int fr, int fq) const {
        const int T = u.pn, cs = u.pm, grp = u.aux; size_t rowstart;
        if (T < 16) rowstart = (size_t)(T >> 3) * 1024 * 4096 + (T & 7) * 512 + cs * 256;
        else { const int b = (T - 16) >> 3, tq = (T - 16) & 7; rowstart = (size_t)(2 + b) * 1024 * 4096 + cs * 2048 + tq * 256; }
        bf16_t* base = zt + rowstart + (size_t)(grp * 256 + wr * 64 + fr) * 4096 + wc * 32 + 8 * fq;
#pragma unroll
        for (int ai = 0; ai < 2; ++ai)
#pragma unroll
            for (int m = 0; m < 4; ++m) { bf16_t* rowp = base + (size_t)(ai * 128 + m * 16) * 4096;
#pragma unroll
                for (int bj = 0; bj < 2; ++bj) { const f32x4 v0 = acc[ai][bj][m][0], v1 = acc[ai][bj][m][1]; u32x4 w;
                    w.x = cvt_pk_bf16(v0[0], v0[1]); w.y = cvt_pk_bf16(v0[2], v0[3]); w.z = cvt_pk_bf16(v1[0], v1[1]); w.w = cvt_pk_bf16(v1[2], v1[3]);
                    *(u32x4*)(rowp + bj * 128) = w; } }
    }
};
struct EpiSeq {
    static constexpr bool PERM = true;
    bf16_t* f; bf16_t* P; unsigned* flags;
    __device__ __forceinline__ void operator()(const f32x4 (&acc)[2][2][4][2], const Unit& u, int wr, int wc, int fr, int fq) const {
        const size_t rowoff = (size_t)(wr * 64 + fr) * D + u.pn * 256 + wc * 32 + 8 * fq;
        if (u.ks > 0) {
            bf16_t* base = P + (size_t)(u.ks - 1) * 4096 * D + (size_t)(u.aux - 4096) * D + rowoff;
#pragma unroll
            for (int ai = 0; ai < 2; ++ai)
#pragma unroll
                for (int m = 0; m < 4; ++m) { bf16_t* rowp = base + (size_t)(ai * 128 + m * 16) * D;
#pragma unroll
                    for (int bj = 0; bj < 2; ++bj) { const f32x4 v0 = acc[ai][bj][m][0], v1 = acc[ai][bj][m][1]; u32x4 w;
                        w.x = cvt_pk_bf16(v0[0], v0[1]); w.y = cvt_pk_bf16(v0[2], v0[3]); w.z = cvt_pk_bf16(v1[0], v1[1]); w.w = cvt_pk_bf16(v1[2], v1[3]);
                        st_wt16(rowp + bj * 128, fq, w); } }
            handoff_publish(flags + u.pm * 16, fr == 0 && fq == 0);
        } else {
            if (u.ks == 0) handoff_wait(flags + u.pm * 16, 24u);
            bf16_t* base = f + (size_t)u.aux * D + rowoff; const bf16_t* pb = P + (size_t)(u.ks == 0 ? u.aux - 4096 : 0) * D + rowoff;
#pragma unroll
            for (int ai = 0; ai < 2; ++ai)
#pragma unroll
                for (int m = 0; m < 4; ++m) { const size_t ro = (size_t)(ai * 128 + m * 16) * D;
#pragma unroll
                    for (int bj = 0; bj < 2; ++bj) { f32x4 v0 = acc[ai][bj][m][0], v1 = acc[ai][bj][m][1];
                        if (u.ks == 0) {
#pragma unroll
                            for (int q = 0; q < 3; ++q) { const u32x4 pw = ld_ag16(pb + (size_t)q * 4096 * D + ro + bj * 128, fq);
                                v0 += (f32x4){bf_lo(pw.x), bf_hi(pw.x), bf_lo(pw.y), bf_hi(pw.y)}; v1 += (f32x4){bf_lo(pw.z), bf_hi(pw.z), bf_lo(pw.w), bf_hi(pw.w)}; } }
                        u32x4 w; w.x = cvt_pk_bf16(v0[0], v0[1]); w.y = cvt_pk_bf16(v0[2], v0[3]); w.z = cvt_pk_bf16(v1[0], v1[1]); w.w = cvt_pk_bf16(v1[2], v1[3]);
                        *(u32x4*)(base + ro + bj * 128) = w; } }
        }
    }
};

template <int CTRL> __device__ __forceinline__ float dpp_f(float old, float src) { return __int_as_float(__builtin_amdgcn_update_dpp(__float_as_int(old), __float_as_int(src), CTRL, 0xf, 0xf, false)); }
struct EpiUpConv {
    static constexpr bool PERM = true;
    bf16_t* act; const float* cw; const float* cb; LAS unsigned char* xl;
    __device__ __forceinline__ void operator()(const f32x4 (&acc)[2][2][4][2], const Unit& u, int wr, int wc, int fr, int fq) const {
        asm volatile("" : "+v"(fr), "+v"(fq));
        const bool ctx = u.pm < 16; const int w = wr * 4 + wc, w2 = (wr ^ 1) * 4 + wc;
        LAS unsigned char* xw = xl + w * 1024 + fq * 16;
        LAS unsigned char* xp = xl + w2 * 1024 + fq * 16 + (wr - 1) * 512;
        LAS unsigned char* xn = xl + w2 * 1024 + fq * 16 + wr * 512;
        if (ctx) {
            if (fr == 0 || fr == 15) { const bool first = fr == 0; LAS unsigned char* xq = xw + (first ? 0 : 256);
#pragma unroll
                for (int ai = 0; ai < 2; ++ai)
#pragma unroll
                    for (int bj = 0; bj < 2; ++bj)
#pragma unroll
                        for (int n = 0; n < 2; ++n) { f32x4 v;
#pragma unroll
                            for (int q = 0; q < 4; ++q) v[q] = first ? acc[ai][bj][0][n][q] : acc[ai][bj][3][n][q];
                            *(LAS f32x4*)(xq + ai * 512 + bj * 128 + n * 64) = v; }
            }
            asm volatile("s_waitcnt lgkmcnt(0)" ::: "memory"); __builtin_amdgcn_s_barrier(); asm volatile("" ::: "memory");
        }
        const int ch0 = u.pn * 128 + wc * 32 + 8 * fq;
        bf16_t* obase = act + (size_t)(u.pm * 256 + wr * 64 + fr) * DFF + ch0;
#pragma unroll
        for (int n = 0; n < 2; ++n) {
            const int cg = ch0 + 4 * n, cvl = DFF + ch0 + 4 * n;
            const f32x4 wg0 = *(const f32x4*)(cw + cg), wg1 = *(const f32x4*)(cw + NUP + cg), wg2 = *(const f32x4*)(cw + 2 * NUP + cg), bg = *(const f32x4*)(cb + cg);
            const f32x4 wv0 = *(const f32x4*)(cw + cvl), wv1 = *(const f32x4*)(cw + NUP + cvl), wv2 = *(const f32x4*)(cw + 2 * NUP + cvl), bv = *(const f32x4*)(cb + cvl);
#pragma unroll
            for (int ai = 0; ai < 2; ++ai) {
                const bool hasp = ctx && (ai == 1 || wr == 1), hasn = ctx && (ai == 0 || wr == 0);
                const f32x4 z4 = {0.f, 0.f, 0.f, 0.f};
                f32x4 pg = *(const LAS f32x4*)(xp + ai * 512 + 256 + 0 * 128 + n * 64), pv = *(const LAS f32x4*)(xp + ai * 512 + 256 + 1 * 128 + n * 64);
                f32x4 ng = *(const LAS f32x4*)(xn + ai * 512 + 0 * 128 + n * 64), nv = *(const LAS f32x4*)(xn + ai * 512 + 1 * 128 + n * 64);
                pg = hasp ? pg : z4; pv = hasp ? pv : z4; ng = hasn ? ng : z4; nv = hasn ? nv : z4;
#pragma unroll
                for (int m = 0; m < 4; ++m) { float res[4];
#pragma unroll
                    for (int q = 0; q < 4; ++q) {
                        const float cgv = acc[ai][0][m][n][q], cvv = acc[ai][1][m][n][q];
                        const float opg = (m == 0) ? pg[q] : dpp_f<0x121>(0.f, acc[ai][0][m == 0 ? 0 : m - 1][n][q]);
                        const float opv = (m == 0) ? pv[q] : dpp_f<0x121>(0.f, acc[ai][1][m == 0 ? 0 : m - 1][n][q]);
                        const float ong = (m == 3) ? ng[q] : dpp_f<0x12F>(0.f, acc[ai][0][m == 3 ? 3 : m + 1][n][q]);
                        const float onv = (m == 3) ? nv[q] : dpp_f<0x12F>(0.f, acc[ai][1][m == 3 ? 3 : m + 1][n][q]);
                        const float prg = dpp_f<0x111>(opg, cgv), prv = dpp_f<0x111>(opv, cvv);
                        const float nxg = dpp_f<0x101>(ong, cgv), nxv = dpp_f<0x101>(onv, cvv);
                        const float G = __builtin_fmaf(wg0[q], prg, __builtin_fmaf(wg1[q], cgv, __builtin_fmaf(wg2[q], nxg, bg[q])));
                        const float V = __builtin_fmaf(wv0[q], prv, __builtin_fmaf(wv1[q], cvv, __builtin_fmaf(wv2[q], nxv, bv[q])));
                        res[q] = G * sigmoidf_(G) * V; }
                    u32x2 o; o.x = cvt_pk_bf16(res[0], res[1]); o.y = cvt_pk_bf16(res[2], res[3]);
                    *(u32x2*)(obase + (size_t)(ai * 128 + m * 16) * DFF + 4 * n) = o; }
                __builtin_amdgcn_sched_barrier(0);
            }
        }
    }
};

constexpr size_t WS_CTL = 512 * 1024, CTL_BYTES = 131072;
constexpr int FL_WF = 4096, FL_DN = FL_WF + 2 * 2048, FL_SQ = FL_DN + 4 * 2048;
constexpr int MISC_OFF = LDS_BYTES - 64;
#define XB_TMO      128
#define XB_XCNT(j)  (256  + 64 * (j))
#define XB_XSUB(j)  (1280 + 64 * (j))
#define XB_XGEN(j)  (2304 + 64 * (j))
#define XB_TOP      3328
#define XB_TOPGEN   3392
#define XCD_BAR_WORDS 3456
#define XB_SPIN_CAP (1u << 18)

__device__ __forceinline__ unsigned xb_ld(unsigned* p)              { return __hip_atomic_load(p, __ATOMIC_RELAXED, __HIP_MEMORY_SCOPE_AGENT); }
__device__ __forceinline__ unsigned xb_add(unsigned* p, unsigned v) { return __hip_atomic_fetch_add(p, v, __ATOMIC_RELAXED, __HIP_MEMORY_SCOPE_AGENT); }
__device__ __forceinline__ unsigned xb_xcc_id() { return (unsigned)__builtin_amdgcn_s_getreg((3 << 11) | 20) & 0xFu; }
#define XB_SPIN(cond, bar) do { unsigned _sp = 0; while (cond) { __builtin_amdgcn_s_sleep(1); \
    if ((++_sp & 255u) == 0u) { if (xb_ld(&(bar)[XB_TMO])) break; if (_sp > XB_SPIN_CAP) { atomicAdd(&(bar)[XB_TMO], 1u); break; } } } } while (0)

struct XcdBarrier {
    unsigned* bar; unsigned x;
    volatile LAS unsigned* st;
};

__device__ __forceinline__ XcdBarrier xcd_barrier_post(unsigned* bar, volatile LAS unsigned* st, const bool t0) {
    XcdBarrier b; b.bar = bar; b.x = xb_xcc_id(); b.st = st;
    if (t0) (void)xb_add(&bar[XB_XCNT(b.x)], 1u);
    return b;
}
__device__ __forceinline__ void xcd_barrier_complete(unsigned* bar, unsigned x, unsigned& nloc, unsigned& nx) {
    const unsigned G = gridDim.x * gridDim.y * gridDim.z;
    unsigned sum, cnt, mine, sp = 0u;
    for (;;) {
        sum = 0u; cnt = 0u; mine = 0u;
#pragma unroll
        for (unsigned j = 0; j < 16; ++j) { const unsigned c = xb_ld(&bar[XB_XCNT(j)]); sum += c; cnt += (c > 0u) ? 1u : 0u; mine = (j == x) ? c : mine; }
        if (sum == G) break;
        __builtin_amdgcn_s_sleep(1);
        if ((++sp & 255u) == 0u) { if (xb_ld(&bar[XB_TMO])) break; if (sp > XB_SPIN_CAP) { atomicAdd(&bar[XB_TMO], 1u); break; } }
    }
    nloc = mine > 0u ? mine : 1u; nx = cnt > 0u ? cnt : 1u;
}

__device__ __forceinline__ void xcd_barrier(const XcdBarrier& b, const bool t0) {
    asm volatile("s_waitcnt vmcnt(0)" ::: "memory");
    __syncthreads();
    if (t0) {
        unsigned* bar = b.bar;
        __builtin_amdgcn_s_waitcnt(0);
        unsigned nloc = b.st[0], nx = b.st[1];
        if (nloc == 0u) { xcd_barrier_complete(bar, b.x, nloc, nx); b.st[0] = nloc; b.st[1] = nx; }
        const unsigned old = xb_add(&bar[XB_XSUB(b.x)], 1u);
        const unsigned gen = old / nloc;
        if (old + 1u == (gen + 1u) * nloc) {
            __builtin_amdgcn_fence(__ATOMIC_RELEASE, "agent");
            asm volatile("s_waitcnt vmcnt(0)" ::: "memory");
            const unsigned og = xb_add(&bar[XB_TOP], 1u);
            const unsigned tg = og / nx;
            if (og + 1u == (tg + 1u) * nx) xb_add(&bar[XB_TOPGEN], 1u);
            else XB_SPIN(xb_ld(&bar[XB_TOPGEN]) == tg, bar);
            __builtin_amdgcn_fence(__ATOMIC_ACQUIRE, "agent");
            xb_add(&bar[XB_XGEN(b.x)], 1u);
            asm volatile("s_waitcnt vmcnt(0)" ::: "memory");
        } else {
            XB_SPIN(xb_ld(&bar[XB_XGEN(b.x)]) == gen, bar);
            __builtin_amdgcn_fence(__ATOMIC_ACQUIRE, "agent");
            asm volatile("s_waitcnt vmcnt(0)" ::: "memory");
        }
    }
    __syncthreads();
}


__device__ __forceinline__ void transpose_item(const float* W, int K, int N, bf16_t* WT, int H, LAS float* scr, int item, int lane) {
    const int nblk = N / 32, kb = item / nblk, nb = item % nblk, k0 = 64 * kb, n0 = 32 * nb;
    int d0 = n0;
    if (H > 0) d0 = (n0 < H) ? (256 * (n0 / 128) + (n0 % 128)) : (256 * ((n0 - H) / 128) + 128 + ((n0 - H) % 128));
    float v[32];
    const float* wp = W + (size_t)(k0 + (lane >> 5)) * N + n0 + (lane & 31);
#pragma unroll
    for (int i = 0; i < 32; ++i) v[i] = __builtin_nontemporal_load(wp + (size_t)(2 * i) * N);
#pragma unroll
    for (int i = 0; i < 32; ++i) scr[(2 * i + (lane >> 5)) * 33 + (lane & 31)] = v[i];
    asm volatile("s_waitcnt lgkmcnt(0)" ::: "memory");
    const int c = lane & 7;
#pragma unroll
    for (int j = 0; j < 4; ++j) { const int n = (lane >> 3) + 8 * j; const LAS float* s = scr + (8 * c) * 33 + n;
        u32x4 o; o.x = cvt_pk_bf16(s[0 * 33], s[1 * 33]); o.y = cvt_pk_bf16(s[2 * 33], s[3 * 33]); o.z = cvt_pk_bf16(s[4 * 33], s[5 * 33]); o.w = cvt_pk_bf16(s[6 * 33], s[7 * 33]);
        *(u32x4*)(WT + (size_t)(d0 + n) * K + k0 + 8 * c) = o; }
    asm volatile("s_waitcnt lgkmcnt(0)" ::: "memory");
}

constexpr int I_GLU = 16 * 64, I_F = 16 * 32, I_UP = 16 * 176, I_DN = 44 * 32;
__device__ __forceinline__ void convert_updown_item(const Params& p, int i, int r, LAS float* scr, int lane) {
    if (r < I_UP) transpose_item(p.w_up + (size_t)i * 1024 * NUP, 1024, NUP, (bf16_t*)(p.ws + WS_WUP) + (size_t)i * NUP * 1024, DFF, scr, r, lane);
    else transpose_item(p.w_down + (size_t)i * DFF * 1024, DFF, 1024, (bf16_t*)(p.ws + WS_WDN) + (size_t)i * 1024 * DFF, 0, scr, r - I_UP, lane);
}
__device__ __forceinline__ void phase_prep(const Params& p, const int tid, LAS unsigned char* lds) {
    const int lane = tid & 63, w = tid >> 6, G = gridDim.x;
    unsigned char* ws = p.ws;
    LAS float* scond = (LAS float*)lds;
    LAS float* red = (LAS float*)(lds + 12288);
    float* mod = (float*)(ws + WS_MOD);
    if (blockIdx.x < 192) {
        for (int q = tid; q < 3072; q += NTHREADS) { const int cv = q >> 10, k = q & 1023; const float v = cv == 0 ? p.c_ctx[k] : p.c[(cv - 1) * 1024 + k]; scond[q] = v * sigmoidf_(v); }
        __syncthreads();
        for (int it = blockIdx.x; it < 192; it += G) {
            const int i = it / 48, n0 = (it % 48) * 128;
            const float* wp = p.w_ada + ((size_t)i * 1024 + w * 128) * 6144 + n0 + 2 * lane;
            float a00 = 0.f, a01 = 0.f, a10 = 0.f, a11 = 0.f, a20 = 0.f, a21 = 0.f;
#pragma unroll 32
            for (int k = 0; k < 128; ++k) { const f32x2 wv = __builtin_nontemporal_load((const f32x2*)(wp + (size_t)k * 6144)); const int kk = w * 128 + k;
                const float s0 = scond[kk], s1 = scond[1024 + kk], s2 = scond[2048 + kk];
                a00 += s0 * wv.x; a01 += s0 * wv.y; a10 += s1 * wv.x; a11 += s1 * wv.y; a20 += s2 * wv.x; a21 += s2 * wv.y; }
            LAS float* r = red + (w * 64 + lane) * 6; r[0] = a00; r[1] = a01; r[2] = a10; r[3] = a11; r[4] = a20; r[5] = a21;
            __syncthreads();
            if (tid < 384) { const int l = tid / 6, e = tid % 6; float s = 0.f;
#pragma unroll
                for (int ww = 0; ww < 8; ++ww) s += red[(ww * 64 + l) * 6 + e];
                const int cv = e >> 1, n = n0 + 2 * l + (e & 1); mod[((size_t)i * 3 + cv) * 6144 + n] = s + p.b_ada[i * 6144 + n]; }
            __syncthreads();
        }
    }
    __syncthreads();
    {
        LAS float* scr = (LAS float*)(lds + 32768 + w * 8704);
        const int rb = (blockIdx.x + G - (192 % G)) % G;
        const int gw = rb * 8 + w, NGW = G * 8;
        constexpr int NITEMS = 2 * I_GLU + 2 * I_F + I_UP + I_DN;
        for (int it = gw; it < NITEMS; it += NGW) {
            int r = it;
            if (r < 2 * I_GLU) { const int j = r / I_GLU; transpose_item(p.w_glu + (size_t)j * 1024 * 2048, 1024, 2048, (bf16_t*)(ws + WS_WGLU) + (size_t)j * 2048 * 1024, 1024, scr, r % I_GLU, lane); continue; } r -= 2 * I_GLU;
            if (r < 2 * I_F) { const int j = r / I_F; transpose_item(p.w_fourier + (size_t)j * 1024 * 1024, 1024, 1024, (bf16_t*)(ws + WS_WF) + (size_t)j * 1024 * 1024, 0, scr, r % I_F, lane); continue; } r -= 2 * I_F;
            convert_updown_item(p, 0, r, scr, lane);
        }
    }
    {
        const int gt = blockIdx.x * NTHREADS + tid, NT = G * NTHREADS;
        bf16_t* al2048 = (bf16_t*)(ws + WS_AL2048);
        const float s2048 = 0.022097086912079608f;
        for (int q = gt; q < 2048 * 512; q += NT) { const int k1 = q >> 9, k0 = (q & 511) * 8; float v[8];
#pragma unroll
            for (int e = 0; e < 8; ++e) { const int k = k0 + e, n1 = k & 2047; const int idx = (k1 * n1) & 2047; const float rv = (float)idx * (1.0f / 2048.0f); v[e] = (k < 2048 ? __builtin_amdgcn_cosf(rv) : -__builtin_amdgcn_sinf(rv)) * s2048; }
            u32x4 o; o.x = cvt_pk_bf16(v[0], v[1]); o.y = cvt_pk_bf16(v[2], v[3]); o.z = cvt_pk_bf16(v[4], v[5]); o.w = cvt_pk_bf16(v[6], v[7]);
            *(u32x4*)(al2048 + (size_t)k1 * 4096 + k0) = o; }
        bf16_t* al256 = (bf16_t*)(ws + WS_AL256);
        for (int q = gt; q < 256 * 64; q += NT) { const int k1 = q >> 6, k0 = (q & 63) * 8; float v[8];
#pragma unroll
            for (int e = 0; e < 8; ++e) { const int k = k0 + e, n1 = k & 255; const int idx = (k1 * n1) & 255; const float rv = (float)idx * (1.0f / 256.0f); v[e] = (k < 256 ? __builtin_amdgcn_cosf(rv) : -__builtin_amdgcn_sinf(rv)) * 0.0625f; }
            u32x4 o; o.x = cvt_pk_bf16(v[0], v[1]); o.y = cvt_pk_bf16(v[2], v[3]); o.z = cvt_pk_bf16(v[4], v[5]); o.w = cvt_pk_bf16(v[6], v[7]);
            *(u32x4*)(al256 + (size_t)k1 * 4096 + k0) = o; }
        bf16_t* dftc = (bf16_t*)(ws + WS_DFTC);
        for (int q = gt; q < 512 * 32; q += NT) { const int r = q >> 5, k0 = (q & 31) * 8; float v[8];
#pragma unroll
            for (int e = 0; e < 8; ++e) { const int n = k0 + e; const int idx = ((r & 255) * n) & 255; const float rv = (float)idx * (1.0f / 256.0f); v[e] = (r < 256 ? __builtin_amdgcn_cosf(rv) : __builtin_amdgcn_sinf(rv)) * 0.0625f; }
            u32x4 o; o.x = cvt_pk_bf16(v[0], v[1]); o.y = cvt_pk_bf16(v[2], v[3]); o.z = cvt_pk_bf16(v[4], v[5]); o.w = cvt_pk_bf16(v[6], v[7]);
            *(u32x4*)(dftc + (size_t)r * 256 + k0) = o; }
        bf16_t* Bm = (bf16_t*)(ws + WS_BM); bf16_t* Cm = (bf16_t*)(ws + WS_CM); float* AB = (float*)(ws + WS_AB); float* A128 = (float*)(ws + WS_A128);
        for (int q = gt; q < 4 * 64 * 64; q += NT) { const int pp = q & 63, g = (q >> 6) & 63, jd = q >> 12;
            const float dt = expf(p.log_dt[jd * 64 + g]); const float lr = p.lam_re[q], li = p.lam_im[q];
            const float ea = lr * dt, eb = li * dt; const float er = expf(ea); float sn, cs; sincosf(eb, &sn, &cs); const float ar = er * cs, ai = er * sn;
            float snh, csh; sincosf(0.5f * eb, &snh, &csh);
            const float dr = expm1f(ea) * cs - 2.0f * snh * snh, di = ai;
            const float den = lr * lr + li * li; const float cr = (dr * lr + di * li) / den, ci = (di * lr - dr * li) / den;
            const float e128 = expf(128.0f * ea); float sn2, cs2; sincosf(128.0f * eb, &sn2, &cs2);
            AB[q * 2] = ar; AB[q * 2 + 1] = ai; A128[q * 2] = e128 * cs2; A128[q * 2 + 1] = e128 * sn2;
            float vr[16], vi[16];
#pragma unroll
            for (int cc = 0; cc < 16; ++cc) { const float br = p.b_re[(size_t)q * 16 + cc], bi = p.b_im[(size_t)q * 16 + cc]; vr[cc] = cr * br - ci * bi; vi[cc] = cr * bi + ci * br; }
            bf16_t* brow = Bm + ((size_t)(jd * 64 + g) * 128 + pp) * 16; bf16_t* irow = brow + 64 * 16;
#pragma unroll
            for (int h = 0; h < 2; ++h) { u32x4 o; o.x = cvt_pk_bf16(vr[8 * h], vr[8 * h + 1]); o.y = cvt_pk_bf16(vr[8 * h + 2], vr[8 * h + 3]); o.z = cvt_pk_bf16(vr[8 * h + 4], vr[8 * h + 5]); o.w = cvt_pk_bf16(vr[8 * h + 6], vr[8 * h + 7]); *(u32x4*)(brow + 8 * h) = o;
                u32x4 o2; o2.x = cvt_pk_bf16(vi[8 * h], vi[8 * h + 1]); o2.y = cvt_pk_bf16(vi[8 * h + 2], vi[8 * h + 3]); o2.z = cvt_pk_bf16(vi[8 * h + 4], vi[8 * h + 5]); o2.w = cvt_pk_bf16(vi[8 * h + 6], vi[8 * h + 7]); *(u32x4*)(irow + 8 * h) = o2; }
#pragma unroll
            for (int cc = 0; cc < 16; ++cc) { const size_t ci2 = ((size_t)(jd * 64 + g) * 16 + cc) * 64 + pp; *(unsigned*)(Cm + ((size_t)(jd * 64 + g) * 16 + cc) * 128 + 2 * pp) = cvt_pk_bf16(p.c_re[ci2], -p.c_im[ci2]); }
        }
    }
}

template <int MODE>
__device__ __forceinline__ void phase_norm(const Params& p, const int tid, bool first, bool pend, const float* gP  , const float* bP  , const float* gn, const float* sc, const float* sh) {
    const int lane = tid & 63, w = tid >> 6, G = gridDim.x;
    float* X = (float*)(p.ws + WS_X); bf16_t* H = (bf16_t*)(p.ws + WS_H);
    constexpr int R = 4;
    const int rstride = G * 8;
    for (int base = blockIdx.x * 8 + w; base < NTOK; base += rstride * R) {
        f32x4 v[R][4];
#pragma unroll
        for (int k = 0; k < R; ++k) { const int m = base + k * rstride; if (m < NTOK) {
            const float* src = first ? (m < 4096 ? p.x_prompt + (size_t)m * D : p.x_sample + (size_t)(m - 4096) * D) : X + (size_t)m * D;
#pragma unroll
            for (int j = 0; j < 2; ++j) { v[k][2 * j] = *(const f32x4*)(src + lane * 8 + 512 * j); v[k][2 * j + 1] = *(const f32x4*)(src + lane * 8 + 512 * j + 4); } } }
#pragma unroll
        for (int k = 0; k < R; ++k) { const int m = base + k * rstride; if (m < NTOK) { const int cv = cond_of_row(m);
            if (MODE == 0 && first) {
#pragma unroll
                for (int j = 0; j < 2; ++j) { *(f32x4*)(X + (size_t)m * D + lane * 8 + 512 * j) = v[k][2 * j]; *(f32x4*)(X + (size_t)m * D + lane * 8 + 512 * j + 4) = v[k][2 * j + 1]; }
            }
            float ss = 0.f;
#pragma unroll
            for (int j = 0; j < 4; ++j) ss += (v[k][j].x * v[k][j].x + v[k][j].y * v[k][j].y) + (v[k][j].z * v[k][j].z + v[k][j].w * v[k][j].w);
            ss = wave_sum(ss, lane);
            const float rstd = 1.0f / sqrtf(ss * (1.0f / 1024.0f) + 1e-6f);
#pragma unroll
            for (int j = 0; j < 2; ++j) { const int col = lane * 8 + 512 * j;
                if (MODE == 0) { u32x4 pk;
#pragma unroll
                    for (int hlf = 0; hlf < 2; ++hlf) { const int c4 = col + 4 * hlf; const f32x4 g = *(const f32x4*)(gn + c4), s1 = *(const f32x4*)(sc + cv * 6144 + c4), s0 = *(const f32x4*)(sh + cv * 6144 + c4); f32x4 o;
#pragma unroll
                        for (int q = 0; q < 4; ++q) o[q] = v[k][2 * j + hlf][q] * rstd * g[q] * (1.0f + s1[q]) + s0[q];
                        if (hlf == 0) { pk.x = cvt_pk_bf16(o[0], o[1]); pk.y = cvt_pk_bf16(o[2], o[3]); } else { pk.z = cvt_pk_bf16(o[0], o[1]); pk.w = cvt_pk_bf16(o[2], o[3]); } }
                    *(u32x4*)(H + (size_t)m * D + col) = pk; }
                else {
#pragma unroll
                    for (int hlf = 0; hlf < 2; ++hlf) { const int c4 = col + 4 * hlf; const f32x4 g = *(const f32x4*)(gn + c4); f32x4 o;
#pragma unroll
                        for (int q = 0; q < 4; ++q) o[q] = v[k][2 * j + hlf][q] * rstd * g[q];
                        *(f32x4*)(p.out + (size_t)m * D + c4) = o; } }
            } } }
    }
}

constexpr int HT_STRIDE = 272;
constexpr int HT_BYTES = 256 * HT_STRIDE;
constexpr int HB_BYTES = 32 * HT_STRIDE;

template <bool P2, int DIR>
__device__ __forceinline__ void s5_dir(const Params& p, int j, int T, int g, int w, int lane, LAS unsigned char* hT, LAS unsigned char* hb, f32x4 (&yacc)[16]) {
    const int n = lane & 31, hh = lane >> 5, jd = j * 2 + DIR;
    const bf16_t* Bm = (const bf16_t*)(p.ws + WS_BM) + (size_t)(jd * 64 + g) * 128 * 16;
    const float* AB = (const float*)(p.ws + WS_AB) + (size_t)(jd * 64 + g) * 128;
    bf16x8 bfr[4];
#pragma unroll
    for (int nb = 0; nb < 4; ++nb) bfr[nb] = *(const bf16x8*)(Bm + (nb * 32 + n) * 16 + hh * 8);
    const float a0r = AB[2 * n], a0i = AB[2 * n + 1], a1r = AB[2 * (32 + n)], a1i = AB[2 * (32 + n) + 1];
    float h0r = 0.f, h0i = 0.f, h1r = 0.f, h1i = 0.f;
    const int sc = 2 * T + hh;
    bf16x8 cfr[4];
    if constexpr (P2) {
        const bf16_t* Cm = (const bf16_t*)(p.ws + WS_CM) + (size_t)(jd * 64 + g) * 16 * 128;
#pragma unroll
        for (int ks = 0; ks < 4; ++ks) cfr[ks] = *(const bf16x8*)(Cm + (lane & 15) * 128 + ks * 32 + (lane >> 4) * 8);
        const float* A128 = (const float*)(p.ws + WS_A128) + (size_t)(jd * 64 + g) * 128;
        const float b0r = A128[2 * n], b0i = A128[2 * n + 1], b1r = A128[2 * (32 + n)], b1i = A128[2 * (32 + n) + 1];
        int sc0, nsc;
        if (T < 16) { sc0 = 2 * T; nsc = 2; }
        else { const int bs = (T - 16) >> 3; sc0 = 32 + 16 * bs; nsc = 16; const size_t si = (size_t)((bs * 2 + j) * 2 + DIR) * 4096 + g * 64;
            h0r = p.st_re[si + n]; h0i = p.st_im[si + n]; h1r = p.st_re[si + 32 + n]; h1i = p.st_im[si + 32 + n]; }
        const float* Sb = (const float*)(p.ws + WS_S) + (size_t)DIR * 64 * 64 * 128 + (size_t)g * 128;
        if (T >= 16) {
            f32x2 s0[15], s1[15];
#pragma unroll
            for (int e = 0; e < 15; ++e) { const int q = DIR == 0 ? sc0 + e : sc0 + 15 - e; const bool ok = DIR == 0 ? q < sc : q > sc;
                const float* sp = Sb + (size_t)(ok ? q : sc) * 64 * 128; s0[e] = *(const f32x2*)(sp + 2 * n); s1[e] = *(const f32x2*)(sp + 2 * (32 + n)); }
#pragma unroll
            for (int e = 0; e < 15; ++e) { const int q = DIR == 0 ? sc0 + e : sc0 + 15 - e; const bool ok = DIR == 0 ? q < sc : q > sc;
                const float t0 = b0r * h0r - b0i * h0i + s0[e].x, t1 = b0r * h0i + b0i * h0r + s0[e].y, t2 = b1r * h1r - b1i * h1i + s1[e].x, t3 = b1r * h1i + b1i * h1r + s1[e].y;
                h0r = ok ? t0 : h0r; h0i = ok ? t1 : h0i; h1r = ok ? t2 : h1r; h1i = ok ? t3 : h1i; }
        } else if ((DIR == 0) == (hh == 1)) {
            const float* sp = Sb + (size_t)(DIR == 0 ? sc0 : sc0 + 1) * 64 * 128; const f32x2 s0 = *(const f32x2*)(sp + 2 * n), s1 = *(const f32x2*)(sp + 2 * (32 + n));
            const float t0 = b0r * h0r - b0i * h0i + s0.x, t1 = b0r * h0i + b0i * h0r + s0.y, t2 = b1r * h1r - b1i * h1i + s1.x, t3 = b1r * h1i + b1i * h1r + s1.y;
            h0r = t0; h0i = t1; h1r = t2; h1i = t3;
        }
    }
    const f32x16 zero16 = {0.f, 0.f, 0.f, 0.f, 0.f, 0.f, 0.f, 0.f, 0.f, 0.f, 0.f, 0.f, 0.f, 0.f, 0.f, 0.f};
#pragma unroll
    for (int bi = 0; bi < 8; ++bi) {
        const int blk = DIR ? 7 - bi : bi;
        const int tokrow = 128 * ((n >> 2) & 1) + 16 * blk + 4 * (n >> 3) + (n & 3);
        const bf16x8 af = *(const LAS bf16x8*)(hT + tokrow * HT_STRIDE + w * 32 + hh * 16);
#pragma unroll
        for (int sh = 0; sh < 2; ++sh) {
            f32x16 br = __builtin_amdgcn_mfma_f32_32x32x16_bf16(af, bfr[sh], zero16, 0, 0, 0);
            f32x16 bim = __builtin_amdgcn_mfma_f32_32x32x16_bf16(af, bfr[2 + sh], zero16, 0, 0, 0);
            const float ar = sh ? a1r : a0r, ai = sh ? a1i : a0i;
            float hr = sh ? h1r : h0r, hi = sh ? h1i : h0i;
#pragma unroll
            for (int rr = 0; rr < 16; ++rr) { const int r = DIR ? 15 - rr : rr;
                const float t0 = __builtin_fmaf(ar, hr, __builtin_fmaf(-ai, hi, br[r])), t1 = __builtin_fmaf(ar, hi, __builtin_fmaf(ai, hr, bim[r])); hr = t0; hi = t1; br[r] = t0; bim[r] = t1; }
            if (sh) { h1r = hr; h1i = hi; } else { h0r = hr; h0i = hi; }
            if constexpr (P2) {
                if (bi == 0 && T < 16 && hh == DIR) {
                    const int r = DIR ? 15 : 0; const size_t oi = (size_t)((T * 2 + j) * 2 + DIR) * 4096 + g * 64 + sh * 32 + n;
                    float* ore = p.out + (size_t)NTOK * D; float* oim = ore + 16 * 2 * 2 * 4096;
                    ore[oi] = br[r]; oim[oi] = bim[r]; }
#pragma unroll
                for (int r = 0; r < 16; ++r) *(LAS unsigned*)(hb + (hh * 16 + r) * HT_STRIDE + (sh * 32 + n) * 4) = cvt_pk_bf16(br[r], bim[r]);
            }
        }
        if constexpr (P2) {
#pragma unroll
            for (int hs = 0; hs < 2; ++hs)
#pragma unroll
                for (int ks = 0; ks < 4; ++ks) { const bf16x8 hf = *(const LAS bf16x8*)(hb + (hs * 16 + (lane & 15)) * HT_STRIDE + ks * 64 + (lane >> 4) * 16);
                    yacc[hs * 8 + blk] = __builtin_amdgcn_mfma_f32_16x16x32_bf16(cfr[ks], hf, yacc[hs * 8 + blk], 0, 0, 0); }
            __builtin_amdgcn_sched_barrier(0);
        }
    }
    if constexpr (!P2) {
        float* So = (float*)(p.ws + WS_S) + ((size_t)(DIR * 64 + sc) * 64 + g) * 128;
        *(f32x2*)(So + 2 * n) = (f32x2){h0r, h0i}; *(f32x2*)(So + 2 * (32 + n)) = (f32x2){h1r, h1i};
    }
}

__device__ __forceinline__ void s5_pass1_item(const Params& p, int j, int T, int g, int w, int lane, LAS unsigned char* hT) {
    const int n = lane & 31, hh = lane >> 5, sc = 2 * T + hh;
    bf16x8 bfr[2][4]; float ar[2][2], ai[2][2], hr[2][2], hi[2][2];
#pragma unroll
    for (int d = 0; d < 2; ++d) { const int jd = j * 2 + d;
        const bf16_t* Bm = (const bf16_t*)(p.ws + WS_BM) + (size_t)(jd * 64 + g) * 128 * 16; const float* AB = (const float*)(p.ws + WS_AB) + (size_t)(jd * 64 + g) * 128;
#pragma unroll
        for (int nb = 0; nb < 4; ++nb) bfr[d][nb] = *(const bf16x8*)(Bm + (nb * 32 + n) * 16 + hh * 8);
#pragma unroll
        for (int sh = 0; sh < 2; ++sh) { ar[d][sh] = AB[2 * (sh * 32 + n)]; ai[d][sh] = AB[2 * (sh * 32 + n) + 1]; hr[d][sh] = 0.f; hi[d][sh] = 0.f; } }
    const f32x16 zero16 = {0.f, 0.f, 0.f, 0.f, 0.f, 0.f, 0.f, 0.f, 0.f, 0.f, 0.f, 0.f, 0.f, 0.f, 0.f, 0.f};
#pragma unroll 1
    for (int bi = 0; bi < 8; ++bi) {
        const int trow = 128 * ((n >> 2) & 1) + 4 * (n >> 3) + (n & 3);
        const bf16x8 af0 = *(const LAS bf16x8*)(hT + (trow + 16 * bi) * HT_STRIDE + w * 32 + hh * 16);
        const bf16x8 af1 = *(const LAS bf16x8*)(hT + (trow + 16 * (7 - bi)) * HT_STRIDE + w * 32 + hh * 16);
        f32x16 br[2][2], bm[2][2];
#pragma unroll
        for (int sh = 0; sh < 2; ++sh) { br[0][sh] = __builtin_amdgcn_mfma_f32_32x32x16_bf16(af0, bfr[0][sh], zero16, 0, 0, 0); bm[0][sh] = __builtin_amdgcn_mfma_f32_32x32x16_bf16(af0, bfr[0][2 + sh], zero16, 0, 0, 0);
            br[1][sh] = __builtin_amdgcn_mfma_f32_32x32x16_bf16(af1, bfr[1][sh], zero16, 0, 0, 0); bm[1][sh] = __builtin_amdgcn_mfma_f32_32x32x16_bf16(af1, bfr[1][2 + sh], zero16, 0, 0, 0); }
#pragma unroll
        for (int rr = 0; rr < 16; ++rr)
#pragma unroll
            for (int d = 0; d < 2; ++d)
#pragma unroll
                for (int sh = 0; sh < 2; ++sh) { const int r = d ? 15 - rr : rr;
                    const float t0 = __builtin_fmaf(ar[d][sh], hr[d][sh], __builtin_fmaf(-ai[d][sh], hi[d][sh], br[d][sh][r])), t1 = __builtin_fmaf(ar[d][sh], hi[d][sh], __builtin_fmaf(ai[d][sh], hr[d][sh], bm[d][sh][r])); hr[d][sh] = t0; hi[d][sh] = t1; }
    }
#pragma unroll
    for (int d = 0; d < 2; ++d) { float* So = (float*)(p.ws + WS_S) + ((size_t)(d * 64 + sc) * 64 + g) * 128;
#pragma unroll
        for (int sh = 0; sh < 2; ++sh) *(f32x2*)(So + 2 * (sh * 32 + n)) = (f32x2){hr[d][sh], hi[d][sh]}; }
}

template <bool P2>
__device__ __forceinline__ void phase_s5(const Params& p, const int tid, int j, LAS unsigned char* lds) {
    const int lane = tid & 63, w = __builtin_amdgcn_readfirstlane(tid >> 6);
    LAS unsigned char* hT = lds; LAS unsigned char* hb = lds + HT_BYTES + w * HB_BYTES;
    const bf16_t* H = (const bf16_t*)(p.ws + WS_H); bf16_t* Y = (bf16_t*)(p.ws + WS_Y);
    for (int item = blockIdx.x; item < 256; item += gridDim.x) {
        const int T = item >> 3, gb = item & 7, g = gb * 8 + w;
        __syncthreads();
        for (int q = tid; q < 4096; q += NTHREADS) { const int r = q >> 4, c16 = q & 15;
            *(LAS u32x4*)(hT + r * HT_STRIDE + c16 * 16) = *(const u32x4*)(H + (size_t)(T * 256 + r) * D + gb * 128 + c16 * 8); }
        __syncthreads();
        f32x4 yacc[16];
#pragma unroll
        for (int i = 0; i < 16; ++i) yacc[i] = (f32x4){0.f, 0.f, 0.f, 0.f};
        if constexpr (P2) { s5_dir<P2, 0>(p, j, T, g, w, lane, hT, hb, yacc); s5_dir<P2, 1>(p, j, T, g, w, lane, hT, hb, yacc); }
        else s5_pass1_item(p, j, T, g, w, lane, hT);
        if constexpr (P2) {
            const int ch4 = 4 * (lane >> 4); const f32x4 dsk = *(const f32x4*)(p.ssm_d + j * 1024 + g * 16 + ch4);
#pragma unroll
            for (int tb = 0; tb < 16; ++tb) { LAS u32x2* ptr = (LAS u32x2*)(hT + (16 * tb + (lane & 15)) * HT_STRIDE + w * 32 + ch4 * 2); const u32x2 hv = *ptr;
                const float v0 = yacc[tb][0] + dsk[0] * bf_lo(hv.x), v1 = yacc[tb][1] + dsk[1] * bf_hi(hv.x), v2 = yacc[tb][2] + dsk[2] * bf_lo(hv.y), v3 = yacc[tb][3] + dsk[3] * bf_hi(hv.y);
                u32x2 o; o.x = cvt_pk_bf16(gelu_tanh(v0), gelu_tanh(v1)); o.y = cvt_pk_bf16(gelu_tanh(v2), gelu_tanh(v3)); *ptr = o; }
            __syncthreads();
            for (int q = tid; q < 4096; q += NTHREADS) { const int r = q >> 4, c16 = q & 15;
                *(u32x4*)(Y + (size_t)(T * 256 + r) * D + gb * 128 + c16 * 8) = *(const LAS u32x4*)(hT + r * HT_STRIDE + c16 * 16); }
        }
    }
    __syncthreads();
}

__device__ __forceinline__ void phase_conv(const Params& p, const int tid, int i) {
    const bf16_t* U = (const bf16_t*)(p.ws + WS_UP); bf16_t* A = (bf16_t*)(p.ws + WS_ACT);
    const float* cw = p.conv_w + (size_t)i * 3 * NUP; const float* cb = p.conv_b + (size_t)i * NUP;
    const int NT = gridDim.x * NTHREADS;
    for (int q = blockIdx.x * NTHREADS + tid; q < NTOK * (DFF / 8); q += NT) {
        const int m = q / (DFF / 8), c8 = (q % (DFF / 8)) * 8;
        const int rl = m < 4096 ? 256 : 64; const int pos = m & (rl - 1);
        const int colg = 256 * (c8 >> 7) + (c8 & 127);
        float res[8];
#pragma unroll
        for (int half = 0; half < 2; ++half) {
            const bf16_t* up = U + (size_t)m * NUP + colg + half * 128; const int wc0 = half * DFF + c8;
            u32x4 cur = *(const u32x4*)up, prv = (u32x4){0u, 0u, 0u, 0u}, nxt = (u32x4){0u, 0u, 0u, 0u};
            if (pos > 0) prv = *(const u32x4*)(up - NUP);
            if (pos < rl - 1) nxt = *(const u32x4*)(up + NUP);
            float vals[8];
#pragma unroll
            for (int e = 0; e < 4; ++e) {
                const int c = wc0 + 2 * e;
                vals[2 * e] = cw[c] * bf_lo(prv[e]) + cw[NUP + c] * bf_lo(cur[e]) + cw[2 * NUP + c] * bf_lo(nxt[e]) + cb[c];
                vals[2 * e + 1] = cw[c + 1] * bf_hi(prv[e]) + cw[NUP + c + 1] * bf_hi(cur[e]) + cw[2 * NUP + c + 1] * bf_hi(nxt[e]) + cb[c + 1];
            }
#pragma unroll
            for (int e = 0; e < 8; ++e) res[e] = half == 0 ? vals[e] * sigmoidf_(vals[e]) : res[e] * vals[e];
        }
        u32x4 o; o.x = cvt_pk_bf16(res[0], res[1]); o.y = cvt_pk_bf16(res[2], res[3]); o.z = cvt_pk_bf16(res[4], res[5]); o.w = cvt_pk_bf16(res[6], res[7]);
        *(u32x4*)(A + (size_t)m * DFF + c8) = o;
    }
}

#ifndef TEST_MASK
#define TEST_MASK 0xffff
#endif
#ifndef PROBE_S
#define PROBE_S (-1)
#endif
constexpr int SPL = PPL + ((PROBE_S >= 0 && PROBE_S < 100) ? 1 : 0);
constexpr int NSTEP = 2 + SPL * DEPTH + (PROBE_S == 100 ? 1 : 0);
__global__ void __launch_bounds__(NTHREADS, 2) fwd_kernel(const Params p_in) {
    extern __shared__ __attribute__((aligned(16))) unsigned char lds_raw[];
    LAS unsigned char* lds = (LAS unsigned char*)lds_raw;
    cg::grid_group grid = cg::this_grid();
    const int G = gridDim.x;
    const int wid0 = __builtin_amdgcn_readfirstlane((int)(threadIdx.x >> 6));
    { const int t = wid0 * 64 + (int)__builtin_amdgcn_mbcnt_hi(~0u, __builtin_amdgcn_mbcnt_lo(~0u, 0u));
      if (t < 16) ((LAS unsigned*)(lds + MISC_OFF))[t] = 0u;
      __syncthreads();
      (void)xcd_barrier_post((unsigned*)(p_in.ws + WS_CTL), (volatile LAS unsigned*)(lds + MISC_OFF), t == 0); }
    for (int ph_ = p_in.ph_lo; ph_ < p_in.ph_hi; ++ph_) {
        const int ph = (PROBE_S == 100) ? (ph_ > 0 ? ph_ - 1 : 0) : ph_;
#if defined(__HIP_DEVICE_COMPILE__)
        const __attribute__((address_space(4))) Params* kq = (const __attribute__((address_space(4))) Params*)__builtin_amdgcn_kernarg_segment_ptr();
        asm volatile("" : "+s"(kq));
        Params p = *kq;
#else
        Params p = p_in;
#endif
        int cb = blockIdx.x, zl = 0;
        asm volatile("" : "+s"(p.ws), "+s"(cb), "+v"(zl));
        const int tid = wid0 * 64 + (int)__builtin_amdgcn_mbcnt_hi(~0u, __builtin_amdgcn_mbcnt_lo(~0u, (unsigned)zl));
        unsigned char* ws = p.ws;
        const float* mod = (const float*)(ws + WS_MOD);
        if (ph == 0) { if (TEST_MASK & 4) phase_prep(p, tid, lds); }
        else if (ph_ == NSTEP - 1) {
            phase_norm<1>(p, tid, false, false, nullptr, nullptr, p.g_final, nullptr, nullptr);
        } else {
            const int i = (ph - 1) / SPL, s0 = (ph - 1) % SPL, s = (PROBE_S >= 0 && PROBE_S < 100 && s0 > PROBE_S) ? s0 - 1 : s0, j = i >> 1; const bool is_s5 = (i & 1) == 0;
            const float* modi = mod + (size_t)i * 3 * 6144;
#if defined(PROBE_PAR)
            if (PROBE_S >= 0 && PROBE_S < 100 && s0 == PROBE_S + 1 && (i & 1) != PROBE_PAR) goto seam;
#endif
            if (s == 0) {
                const float* modp = mod + (size_t)(i > 0 ? i - 1 : 0) * 3 * 6144;
                const bool rep_ = (PROBE_S == 0 && s0 == 1);
                phase_norm<0>(p, tid, i == 0 && !rep_, false, modp + 5120, nullptr, p.g_mix + i * D, modi + 1024, modi);
            } else if (s == 1) {
                if (is_s5) { if (TEST_MASK & 1) phase_s5<false>(p, tid, j, lds); }
                else { SchedChan S{(const char*)(ws + WS_DFTC), (const char*)(ws + WS_H), G, cb}; EpiChan E{(bf16_t*)(ws + WS_ZT)};
                    if (TEST_MASK & 8) pg8::gemm_phase<EpiChan, SchedChan, false, true>(tid, lds, 256, 1024, S, E); }
            } else if (s == 2) {
                if (is_s5) { if (TEST_MASK & 2) phase_s5<true>(p, tid, j, lds); }
                else { SchedSeqH S{(const char*)(ws + WS_AL256), (const char*)(ws + WS_AL2048), (const char*)(ws + WS_ZT), G, cb}; EpiSeqH E{(bf16_t*)(ws + WS_Y)};
                    if (TEST_MASK & 16) pg8::gemm_phase<EpiSeqH, SchedSeqH, false, true, true>(tid, lds, 4096, 4096, S, E); }
            } else if (s == 3) {
                if (is_s5) { SchedStd S{(const char*)(ws + WS_Y), (const char*)(ws + WS_WGLU) + (size_t)j * 2048 * 1024 * 2, 32, 8, 1, 1024, 1024, 16, G, cb, 256};
                    EpiGlu E{(float*)(ws + WS_X), p.b_glu + j * 2048, modi + 2048};
                    if (TEST_MASK & 32) pg8::gemm_phase<EpiGlu, SchedStd, false, true>(tid, lds, 1024, 1024, S, E); }
                else { SchedStd S{(const char*)(ws + WS_Y), (const char*)(ws + WS_WF) + (size_t)j * 1024 * 1024 * 2, 32, 8, 1, 1024, 1024, 16, G, cb, 128};
                    EpiResidH E{(float*)(ws + WS_X), modi + 2048, p.b_fourier + j * D};
                    if (TEST_MASK & 64) pg8::gemm_phase<EpiResidH, SchedStd, false, true, true>(tid, lds, 1024, 1024, S, E); }
            } else if (s == 4) {
                const bool rep_ = (PROBE_S == 4 && s0 == 5);
                phase_norm<0>(p, tid, false, false, modi + 2048, p.b_fourier + j * D, p.g_ffn + i * D, modi + 4096, modi + 3072);
            } else if (s == 5) {
                SchedStd S{(const char*)(ws + WS_H), (const char*)(ws + WS_WUP) + (size_t)i * NUP * 1024 * 2, 32, 22, 1, 1024, 1024, 16, G, cb, 256};
                EpiUpConv E{(bf16_t*)(ws + WS_ACT), p.conv_w + (size_t)i * 3 * NUP, p.conv_b + (size_t)i * NUP, lds + pg8::STAGE_BYTES};
                if (TEST_MASK & 128) pg8::gemm_phase<EpiUpConv, SchedStd, true, true>(tid, lds, 1024, 1024, S, E);
                if (i + 1 < DEPTH) {
                    const int nfull = 704 % G, nidle = nfull ? G - nfull : G, first = nfull ? nfull : 0;
                    if (cb >= first) { const int wv = __builtin_amdgcn_readfirstlane(tid >> 6); LAS float* scr = (LAS float*)(lds + wv * 8704);
                        for (int it = (cb - first) * 8 + wv; it < I_UP + I_DN; it += nidle * 8) convert_updown_item(p, i + 1, it, scr, tid & 63); }
                }
            } else {
                SchedStd S{(const char*)(ws + WS_ACT), (const char*)(ws + WS_WDN) + (size_t)i * 1024 * DFF * 2, 32, 8, 1, DFF, DFF, 44, G, cb, 128};
                EpiResidH E{(float*)(ws + WS_X), modi + 5120, nullptr};
                if (TEST_MASK & 256) pg8::gemm_phase<EpiResidH, SchedStd, false, true, true>(tid, lds, DFF, DFF, S, E);
            }
        }
#if defined(PROBE_PAR)
        seam:
#endif
        if (ph_ + 1 < p_in.ph_hi) { if (p_in.ph_hi < 0) grid.sync(); else { XcdBarrier xbar; xbar.bar = (unsigned*)(p_in.ws + WS_CTL); xbar.x = xb_xcc_id(); xbar.st = (volatile LAS unsigned*)(lds + MISC_OFF); xcd_barrier(xbar, tid == 0); } }
    }
}

#ifndef N_LAUNCH_MODE
#define N_LAUNCH_MODE 1
#endif
extern "C" void kernel_launch(void* const* d_in, const int* in_sizes, int n_in, void* d_out, int out_size, void* d_ws, size_t ws_size, hipStream_t stream) {
    static int grid = 0;
    if (grid == 0) {
        if (n_in != 27 || ws_size < WS_END) { fprintf(stderr, "kernel_launch: unexpected inputs (n_in %d, ws %zu)\n", n_in, ws_size); grid = -1; return; }
        int dev = 0, cus = 0, per_cu = 0;
        hipGetDevice(&dev); hipDeviceGetAttribute(&cus, hipDeviceAttributeMultiprocessorCount, dev);
        if (hipFuncSetAttribute((const void*)fwd_kernel, hipFuncAttributeMaxDynamicSharedMemorySize, LDS_BYTES) != hipSuccess) { fprintf(stderr, "kernel_launch: hipFuncSetAttribute failed\n"); grid = -1; return; }
        if (hipOccupancyMaxActiveBlocksPerMultiprocessor(&per_cu, (const void*)fwd_kernel, NTHREADS, LDS_BYTES) != hipSuccess || per_cu < 1) { fprintf(stderr, "kernel_launch: occupancy query says %d\n", per_cu); per_cu = 1; }
        (void)hipGetLastError();
        grid = cus * per_cu;
        if (grid > 256) grid = 256;
    }
    if (grid < 0) return;
    Params p{};
    const float** f = (const float**)&p;
    for (int i = 0; i < 27; ++i) f[i] = (const float*)d_in[i];
    p.out = (float*)d_out; p.ws = (unsigned char*)d_ws;
#if N_LAUNCH_MODE == 1
    (void)hipMemsetAsync((char*)d_ws + WS_CTL, 0, CTL_BYTES, stream);
    p.ph_lo = 0; p.ph_hi = NSTEP;
    void* args[] = {&p};
    hipError_t e = hipLaunchCooperativeKernel((const void*)fwd_kernel, dim3(grid), dim3(NTHREADS), args, LDS_BYTES, stream);
    if (e != hipSuccess) fprintf(stderr, "cooperative launch failed: %s (grid %d)\n", hipGetErrorString(e), grid);
#else
    for (int ph = 0; ph < NSTEP; ++ph) { p.ph_lo = ph; p.ph_hi = ph + 1; hipLaunchKernelGGL(fwd_kernel, dim3(grid), dim3(NTHREADS), LDS_BYTES, stream, p); }
#endif
}
```

```cpp
#include <hip/hip_runtime.h>
#include <hip/hip_cooperative_groups.h>
#include <cstdio>
#include <cstdint>
namespace cg = cooperative_groups;

#define LAS __attribute__((address_space(3)))
#define GAS __attribute__((address_space(1)))
typedef unsigned short bf16_t;
typedef short bf16x8 __attribute__((ext_vector_type(8)));
typedef float f32x4 __attribute__((ext_vector_type(4)));
typedef float f32x2 __attribute__((ext_vector_type(2)));
typedef float f32x16 __attribute__((ext_vector_type(16)));
typedef unsigned u32x4 __attribute__((ext_vector_type(4)));
typedef unsigned u32x2 __attribute__((ext_vector_type(2)));

constexpr int D = 1024, NTOK = 8192, DFF = 2816, NUP = 5632, DEPTH = 4;
constexpr int PPL = 7;
constexpr int NPHASE = 2 + PPL * DEPTH;
constexpr int NTHREADS = 512;

constexpr size_t MiB = 1u << 20;
constexpr size_t WS_MOD = 0;
constexpr size_t WS_BM = 1 * MiB;
constexpr size_t WS_CM = 2 * MiB;
constexpr size_t WS_AB = 3 * MiB;
constexpr size_t WS_A128 = 3 * MiB + 512 * 1024;
constexpr size_t WS_S = 4 * MiB;
constexpr size_t WS_DFTC = 8 * MiB;
constexpr size_t WS_AL256 = 9 * MiB;
constexpr size_t WS_AL2048 = 11 * MiB;
constexpr size_t WS_WGLU = 27 * MiB;
constexpr size_t WS_WF = 35 * MiB;
constexpr size_t WS_WUP = 39 * MiB;
constexpr size_t WS_WDN = 83 * MiB;
constexpr size_t WS_X = 105 * MiB;
constexpr size_t WS_H = 137 * MiB;
constexpr size_t WS_Y = 153 * MiB;
constexpr size_t WS_UP = 169 * MiB;
constexpr size_t WS_P = WS_UP;
constexpr size_t WS_ACT = 257 * MiB;
constexpr size_t WS_ZT = WS_ACT;
constexpr size_t WS_END = 301 * MiB;

constexpr int LDS_BYTES = 147456;

struct Params {
    const float *x_prompt, *x_sample, *st_re, *st_im, *c, *c_ctx;
    const float *w_ada, *b_ada, *g_mix, *g_ffn;
    const float *lam_re, *lam_im, *log_dt, *b_re, *b_im, *c_re, *c_im, *ssm_d;
    const float *w_glu, *b_glu, *w_fourier, *b_fourier, *w_up, *conv_w, *conv_b, *w_down, *g_final;
    float* out; unsigned char* ws;
    int ph_lo, ph_hi;
};

__device__ __forceinline__ unsigned cvt_pk_bf16(float lo, float hi) { unsigned r; asm("v_cvt_pk_bf16_f32 %0, %1, %2" : "=v"(r) : "v"(lo), "v"(hi)); return r; }
__device__ __forceinline__ float bf_lo(unsigned u) { return __uint_as_float(u << 16); }
__device__ __forceinline__ float bf_hi(unsigned u) { return __uint_as_float(u & 0xffff0000u); }
__device__ __forceinline__ float sigmoidf_(float t) { return __builtin_amdgcn_rcpf(1.0f + __expf(-t)); }
__device__ __forceinline__ float gelu_tanh(float v) { const float t = v * __builtin_fmaf(0.0713548162726f, v * v, 1.5957691216057308f); return v * sigmoidf_(t); }
__device__ __forceinline__ float wave_sum(float v, int lane) {
#pragma unroll
    for (int o = 1; o < 64; o <<= 1) v += __int_as_float(__builtin_amdgcn_ds_bpermute((lane ^ o) << 2, __float_as_int(v)));
    return v;
}
__device__ __forceinline__ int cond_of_row(int m) { return m < 4096 ? 0 : 1 + ((m - 4096) >> 11); }

namespace pg8 {
constexpr int BM = 256, BK = 64, HALF = 128, HTB = HALF * BK * 2, STAGE_BYTES = 8 * HTB, NXCD = 8, WGM = 8;
__host__ __device__ __forceinline__ int lds_byte(int r, int c) { const int st = (r >> 4) * 2 + (c >> 5), rr = r & 15, cc = c & 31, ob = rr * 64 + cc * 2; return st * 1024 + (ob ^ (((ob >> 9) & 1) << 5)); }
__host__ __device__ __forceinline__ void stage_rc(int b, int& R, int& C) { const int st = b / 1024, sb = b % 1024, swz = sb ^ (((sb >> 9) & 1) << 5); R = (st >> 1) * 16 + swz / 64; C = (st & 1) * 32 + (swz % 64) / 2; }
__host__ __device__ __forceinline__ int perm32(int rho) { const int n = rho >> 4, i = rho & 15; return 8 * (i >> 2) + 4 * n + (i & 3); }

struct Unit { int pm, pn, aux, nt, ks; const char* A; const char* B; };

__device__ __forceinline__ int xcd_remap(int L, int nwg) { const int q = nwg / NXCD, r = nwg % NXCD, xcd = L % NXCD, off = L / NXCD; return (xcd < r ? xcd * (q + 1) : r * (q + 1) + (xcd - r) * q) + off; }
__device__ __forceinline__ void tile_of(int wgid, int nM, int nN, int& pm, int& pn) { const int nig = WGM * nN, gid = wgid / nig, fm = gid * WGM, gsz = (nM - fm) < WGM ? (nM - fm) : WGM; pm = fm + ((wgid % nig) % gsz); pn = (wgid % nig) / gsz; }

template <class Epi, class Sched, bool ALIGN_EPI, bool SP2, bool HALFN = false>
__device__ __forceinline__ void gemm_phase(const int tid, LAS unsigned char* lds, const int lda, const int ldb, const Sched& S, const Epi& E) {
    const int wid = __builtin_amdgcn_readfirstlane(tid >> 6), lane = tid & 63, wr = wid >> 2, wc = wid & 3, fr = lane & 15, fq = lane >> 4;
    unsigned voffA[2], voffB[2];
#pragma unroll
    for (int i = 0; i < 2; ++i) { int R, C; stage_rc(tid * 16 + i * 8192, R, C); const int Rb = Epi::PERM ? ((R & ~31) + perm32(R & 31)) : R;
        voffA[i] = (unsigned)(R * lda + C) * 2u; voffB[i] = (unsigned)(Rb * ldb + C) * 2u; }
    const size_t kstep = (size_t)(BK * 2);
    const size_t hA = (size_t)HALF * lda * 2, hB = HALFN ? (size_t)0 : (size_t)HALF * ldb * 2;
    const unsigned ldsw = (unsigned)wid * 1024u;
    const int aoff = lds_byte(wr * 64 + fr, fq * 8), boff = lds_byte(wc * 32 + fr, fq * 8);
#define PG8_SA(b, h) (((b) * 2 + (h)) * HTB)
#define PG8_SB(b, h) ((4 + (b) * 2 + (h)) * HTB)
#define PG8_STAGE(bufoff, gbase, voff) do { _Pragma("unroll") for (int _i = 0; _i < 2; ++_i) \
        __builtin_amdgcn_global_load_lds((const unsigned*)((const char*)(gbase) + (voff)[_i]), (LAS unsigned*)(lds + (bufoff) + ldsw + _i * 8192), 16, 0, 0); } while (0)
#define PG8_LDA(dst, b, h) do { _Pragma("unroll") for (int m = 0; m < 4; ++m) _Pragma("unroll") for (int k = 0; k < 2; ++k) dst[m][k] = *(const LAS bf16x8*)(lds + PG8_SA(b, h) + aoff + m * 2048 + k * 1024); } while (0)
#define PG8_LDB(dst, b, h) do { _Pragma("unroll") for (int n = 0; n < 2; ++n) _Pragma("unroll") for (int k = 0; k < 2; ++k) dst[n][k] = *(const LAS bf16x8*)(lds + PG8_SB(b, h) + boff + n * 2048 + k * 1024); } while (0)
#define PG8_MMA(ai, bj, At, Bt) do { __builtin_amdgcn_s_setprio(1); _Pragma("unroll") for (int m = 0; m < 4; ++m) _Pragma("unroll") for (int n = 0; n < 2; ++n) _Pragma("unroll") for (int k = 0; k < 2; ++k) \
        acc[ai][bj][m][n] = __builtin_amdgcn_mfma_f32_16x16x32_bf16(Bt[n][k], At[m][k], acc[ai][bj][m][n], 0, 0, 0); __builtin_amdgcn_s_setprio(0); } while (0)
#define PG8_WAIT_V(n) asm volatile("s_waitcnt vmcnt(" #n ")" ::: "memory")
#define PG8_WAIT_L(n) asm volatile("s_waitcnt lgkmcnt(" #n ")" ::: "memory")
#define PG8_BAR __builtin_amdgcn_s_barrier()
#define PG8_SCHED __builtin_amdgcn_sched_barrier(0)
    Unit cur, nxt; int ui = 0;
    if (!S.next(0, cur)) return;
    f32x4 acc[2][2][4][2];
#pragma unroll
    for (int a = 0; a < 2; ++a)
#pragma unroll
        for (int b = 0; b < 2; ++b)
#pragma unroll
            for (int m = 0; m < 4; ++m)
#pragma unroll
                for (int n = 0; n < 2; ++n) acc[a][b][m][n] = (f32x4){0.f, 0.f, 0.f, 0.f};
    bf16x8 At[4][2], B0[2][2], B1[2][2];
    const char* cA = cur.A; const char* cB = cur.B;
    if constexpr (SP2) {
        PG8_STAGE(PG8_SB(0, 0), cB, voffB); PG8_STAGE(PG8_SB(0, 1), cB + hB, voffB); PG8_STAGE(PG8_SA(0, 0), cA, voffA); PG8_STAGE(PG8_SA(0, 1), cA + hA, voffA);
        if (wr == 1) PG8_BAR;
        PG8_WAIT_V(2); PG8_BAR;
        PG8_STAGE(PG8_SB(1, 0), cB + kstep, voffB); PG8_STAGE(PG8_SA(1, 0), cA + kstep, voffA); PG8_STAGE(PG8_SB(1, 1), cB + hB + kstep, voffB);
        PG8_WAIT_V(6); PG8_BAR;
    } else {
        PG8_STAGE(PG8_SB(0, 0), cB, voffB); PG8_STAGE(PG8_SA(0, 0), cA, voffA); PG8_STAGE(PG8_SB(0, 1), cB + hB, voffB); PG8_STAGE(PG8_SA(0, 1), cA + hA, voffA);
        if (wr == 1) PG8_BAR;
        PG8_WAIT_V(4); PG8_BAR;
        PG8_STAGE(PG8_SB(1, 0), cB + kstep, voffB); PG8_STAGE(PG8_SA(1, 0), cA + kstep, voffA); PG8_STAGE(PG8_SB(1, 1), cB + hB + kstep, voffB);
        PG8_WAIT_V(6); PG8_BAR;
    }
    for (;;) {
        const bool has_next = S.next(ui + 1, nxt);
        const char* nA = has_next ? nxt.A : cA; const char* nB = has_next ? nxt.B : cB;
        int nt = cur.nt; asm volatile("" : "+s"(nt));
#pragma nounroll
        for (int t = 0; t < nt; t += 2) {
            const bool last = (t == nt - 2);
            const char* a1 = cA + (size_t)(t + 1) * kstep;
            const char* a2 = last ? nA : cA + (size_t)(t + 2) * kstep; const char* b2 = last ? nB : cB + (size_t)(t + 2) * kstep;
            const char* a3 = a2 + kstep; const char* b3 = b2 + kstep;
            if constexpr (SP2) {
            PG8_LDB(B0, 0, 0); if constexpr (!HALFN) PG8_LDB(B1, 0, 1); PG8_SCHED; PG8_LDA(At, 0, 0); PG8_STAGE(PG8_SA(1, 1), a1 + hA, voffA);
            PG8_WAIT_V(8); PG8_WAIT_L(0); PG8_BAR; PG8_MMA(0, 0, At, B0); if constexpr (!HALFN) PG8_MMA(0, 1, At, B1); PG8_BAR; PG8_SCHED;
            PG8_LDA(At, 0, 1); PG8_STAGE(PG8_SB(0, 0), b2, voffB); PG8_STAGE(PG8_SB(0, 1), b2 + hB, voffB); PG8_STAGE(PG8_SA(0, 0), a2, voffA);
            PG8_WAIT_V(8); PG8_WAIT_L(0); PG8_BAR; PG8_MMA(1, 0, At, B0); if constexpr (!HALFN) PG8_MMA(1, 1, At, B1); PG8_BAR; PG8_SCHED;
            PG8_LDB(B0, 1, 0); if constexpr (!HALFN) PG8_LDB(B1, 1, 1); PG8_SCHED; PG8_LDA(At, 1, 0); PG8_STAGE(PG8_SA(0, 1), a2 + hA, voffA);
            PG8_WAIT_V(8); PG8_WAIT_L(0); PG8_BAR; PG8_MMA(0, 0, At, B0); if constexpr (!HALFN) PG8_MMA(0, 1, At, B1); PG8_BAR; PG8_SCHED;
            PG8_LDA(At, 1, 1); PG8_STAGE(PG8_SB(1, 0), b3, voffB); PG8_STAGE(PG8_SB(1, 1), b3 + hB, voffB); PG8_STAGE(PG8_SA(1, 0), a3, voffA);
            PG8_WAIT_V(8); PG8_WAIT_L(0); PG8_BAR; PG8_MMA(1, 0, At, B0); if constexpr (!HALFN) PG8_MMA(1, 1, At, B1); PG8_BAR; PG8_SCHED;
            } else {
            PG8_LDB(B0, 0, 0); PG8_SCHED; PG8_LDA(At, 0, 0); PG8_STAGE(PG8_SA(1, 1), a1 + hA, voffA);
            PG8_WAIT_L(8); PG8_BAR; PG8_WAIT_L(0); PG8_MMA(0, 0, At, B0); PG8_BAR; PG8_SCHED;
            PG8_LDB(B1, 0, 1); PG8_STAGE(PG8_SB(0, 0), b2, voffB);
            PG8_BAR; PG8_WAIT_L(0); PG8_MMA(0, 1, At, B1); PG8_BAR;
            PG8_LDA(At, 0, 1); PG8_STAGE(PG8_SA(0, 0), a2, voffA);
            PG8_BAR; PG8_WAIT_L(0); PG8_MMA(1, 0, At, B0); PG8_BAR; PG8_SCHED;
            PG8_STAGE(PG8_SB(0, 1), b2 + hB, voffB);
            PG8_WAIT_V(6); PG8_BAR; PG8_MMA(1, 1, At, B1); PG8_BAR;
            PG8_LDB(B0, 1, 0); PG8_SCHED; PG8_LDA(At, 1, 0); PG8_STAGE(PG8_SA(0, 1), a2 + hA, voffA);
            PG8_WAIT_L(8); PG8_BAR; PG8_WAIT_L(0); PG8_MMA(0, 0, At, B0); PG8_BAR; PG8_SCHED;
            PG8_LDB(B1, 1, 1); PG8_STAGE(PG8_SB(1, 0), b3, voffB);
            PG8_BAR; PG8_WAIT_L(0); PG8_MMA(0, 1, At, B1); PG8_BAR;
            PG8_LDA(At, 1, 1); PG8_STAGE(PG8_SA(1, 0), a3, voffA);
            PG8_BAR; PG8_WAIT_L(0); PG8_MMA(1, 0, At, B0); PG8_BAR; PG8_SCHED;
            PG8_STAGE(PG8_SB(1, 1), b3 + hB, voffB);
            PG8_WAIT_V(6); PG8_BAR; PG8_MMA(1, 1, At, B1); PG8_BAR;
            }
        }
        if constexpr (ALIGN_EPI) { if (wr == 0) PG8_BAR; }
        { int z = 0; asm volatile("" : "+v"(z)); const int ln = __builtin_amdgcn_mbcnt_hi(~0u, __builtin_amdgcn_mbcnt_lo(~0u, z));
          E(acc, cur, wr, wc, ln & 15, ln >> 4); }
        if (!has_next) break;
#pragma unroll
        for (int a = 0; a < 2; ++a)
#pragma unroll
            for (int b = 0; b < 2; ++b)
#pragma unroll
                for (int m = 0; m < 4; ++m)
#pragma unroll
                    for (int n = 0; n < 2; ++n) acc[a][b][m][n] = (f32x4){0.f, 0.f, 0.f, 0.f};
        cur = nxt; cA = nA; cB = nB; ++ui;
        if constexpr (ALIGN_EPI) { if (wr == 1) PG8_BAR; }
    }
    PG8_WAIT_V(0);
    if constexpr (!ALIGN_EPI) { if (wr == 0) PG8_BAR; }
    PG8_BAR;
#undef PG8_SA
#undef PG8_SB
#undef PG8_STAGE
#undef PG8_LDA
#undef PG8_LDB
#undef PG8_MMA
#undef PG8_WAIT_V
#undef PG8_WAIT_L
#undef PG8_BAR
#undef PG8_SCHED
}
}
using pg8::Unit;

struct SchedStd {
    const char* A; const char* B; int nM, nN, KS, lda, ldb, ntsplit, G, c, bn;
    __device__ __forceinline__ bool next(int i, Unit& u) const {
        const int nwg = nM * nN, tot = nwg * KS; const int L = i * G + c; if (L >= tot) return false;
        const int id = pg8::xcd_remap(L, tot); const int ks = KS - 1 - id / nwg, w = id % nwg; int pm, pn; pg8::tile_of(w, nM, nN, pm, pn);
        u.pm = pm; u.pn = pn; u.aux = ks; u.ks = ks; u.nt = ntsplit;
        u.A = A + ((size_t)pm * 256 * lda + (size_t)ks * ntsplit * 64) * 2; u.B = B + ((size_t)pn * bn * ldb + (size_t)ks * ntsplit * 64) * 2; return true;
    }
};
struct SchedChan {
    const char* dftc; const char* h; int G, c;
    __device__ __forceinline__ bool next(int i, Unit& u) const {
        const int L = i * G + c; if (L >= 256) return false;
        const int pm = L & 1, grp = (L >> 1) & 3, T = L >> 3;
        u.pm = pm; u.pn = T; u.aux = grp; u.nt = 4; u.ks = 0;
        u.A = dftc + (size_t)pm * 256 * 256 * 2; u.B = h + ((size_t)T * 256 * 1024 + grp * 256) * 2; return true;
    }
};
struct SchedSeq {
    const char* al256; const char* al2048; const char* zt; int G, c;
    __device__ __forceinline__ bool next(int i, Unit& u) const {
        const int L = i * G + c; if (L >= 320) return false;
        if (L < 256) { const int ksid = L >> 6, t = L & 63, ks = (ksid + 1) & 3;
            const int b = t >> 5, pm = (t >> 2) & 7, pn = t & 3;
            u.pm = t; u.pn = pn; u.aux = 4096 + b * 2048 + pm * 256; u.nt = 16; u.ks = ks;
            u.A = al2048 + ((size_t)pm * 256 * 4096 + ks * 1024) * 2; u.B = zt + ((size_t)2 * 1024 * 4096 + ((size_t)b * 1024 + pn * 256) * 4096 + ks * 1024) * 2; }
        else { const int l = L - 256, sq = l >> 2, pn = l & 3;
            u.pm = 0; u.pn = pn; u.aux = sq * 256; u.nt = 8; u.ks = -1;
            u.A = al256; u.B = zt + (((size_t)(sq >> 3) * 1024 + pn * 256) * 4096 + (sq & 7) * 512) * 2; }
        return true;
    }
};

struct SchedSeqH {
    const char* al256; const char* al2048; const char* zt; int G, c;
    __device__ __forceinline__ bool next(int i, Unit& u) const {
        const int L = i * G + c; if (L >= 256) return false;
        if (L < 128) { const int b = L >> 6, pm = (L >> 3) & 7, pn = L & 7;
            u.pm = pm; u.pn = pn; u.aux = 4096 + b * 2048 + pm * 256; u.nt = 64; u.ks = 0;
            u.A = al2048 + (size_t)pm * 256 * 4096 * 2; u.B = zt + ((size_t)2 * 1024 * 4096 + ((size_t)b * 1024 + pn * 128) * 4096) * 2; }
        else { const int l = L - 128, sq = l >> 3, pn = l & 7;
            u.pm = 0; u.pn = pn; u.aux = sq * 256; u.nt = 8; u.ks = 0;
            u.A = al256; u.B = zt + (((size_t)(sq >> 3) * 1024 + pn * 128) * 4096 + (sq & 7) * 512) * 2; }
        return true;
    }
};

struct EpiGlu {
    static constexpr bool PERM = false;
    float* x; const float* bias; const float* mod_g;
    __device__ __forceinline__ void operator()(const f32x4 (&acc)[2][2][4][2], const Unit& u, int wr, int wc, int fr, int fq) const {
        const int cv = u.pm < 16 ? 0 : 1 + ((u.pm - 16) >> 3);
        const int ch0 = u.pn * 128 + wc * 32 + 4 * fq;
        f32x4 b1[2], b2[2], gg[2];
#pragma unroll
        for (int n = 0; n < 2; ++n) { b1[n] = *(const f32x4*)(bias + ch0 + 16 * n); b2[n] = *(const f32x4*)(bias + 1024 + ch0 + 16 * n); gg[n] = *(const f32x4*)(mod_g + cv * 6144 + ch0 + 16 * n); }
#pragma unroll
        for (int ai = 0; ai < 2; ++ai)
#pragma unroll
            for (int m = 0; m < 4; ++m) { float* rowp = x + (size_t)(u.pm * 256 + ai * 128 + wr * 64 + m * 16 + fr) * D + ch0;
#pragma unroll
                for (int n = 0; n < 2; ++n) { const f32x4 z1 = acc[ai][0][m][n] + b1[n], z2 = acc[ai][1][m][n] + b2[n]; f32x4 xv = *(const f32x4*)(rowp + 16 * n);
#pragma unroll
                    for (int q = 0; q < 4; ++q) xv[q] += gg[n][q] * (z1[q] * sigmoidf_(z2[q]));
                    *(f32x4*)(rowp + 16 * n) = xv; } }
    }
};
typedef unsigned long long u64_t;
__device__ __forceinline__ void st_wt16(bf16_t* p, int fq, u32x4 w) {
    GAS u64_t* q = (GAS u64_t*)(p - 8 * fq) + fq;
    __hip_atomic_store(q, (u64_t)w.x | ((u64_t)w.y << 32), __ATOMIC_RELAXED, __HIP_MEMORY_SCOPE_AGENT);
    __hip_atomic_store(q + 4, (u64_t)w.z | ((u64_t)w.w << 32), __ATOMIC_RELAXED, __HIP_MEMORY_SCOPE_AGENT);
}
__device__ __forceinline__ u32x4 ld_ag16(const bf16_t* p, int fq) {
    const GAS u64_t* q = (const GAS u64_t*)(p - 8 * fq) + fq;
    const u64_t a = __hip_atomic_load(q, __ATOMIC_RELAXED, __HIP_MEMORY_SCOPE_AGENT), b = __hip_atomic_load(q + 4, __ATOMIC_RELAXED, __HIP_MEMORY_SCOPE_AGENT);
    return (u32x4){(unsigned)a, (unsigned)(a >> 32), (unsigned)b, (unsigned)(b >> 32)};
}
__device__ __forceinline__ void handoff_publish(unsigned* flag, bool lane0) {
    asm volatile("s_waitcnt vmcnt(0)" ::: "memory");
    if (lane0) (void)__hip_atomic_fetch_add(flag, 1u, __ATOMIC_RELAXED, __HIP_MEMORY_SCOPE_AGENT);
}
__device__ __forceinline__ void handoff_wait(unsigned* flag, unsigned want) {
    unsigned spins = 0;
    while (__hip_atomic_load(flag, __ATOMIC_RELAXED, __HIP_MEMORY_SCOPE_AGENT) < want) { __builtin_amdgcn_s_sleep(2); if (++spins > (1u << 22)) break; }
    asm volatile("" ::: "memory");
}
struct EpiPartial {
    static constexpr bool PERM = true;
    bf16_t* P;
    __device__ __forceinline__ void operator()(const f32x4 (&acc)[2][2][4][2], const Unit& u, int wr, int wc, int fr, int fq) const {
        bf16_t* base = P + (size_t)u.aux * NTOK * D + (size_t)(u.pm * 256 + wr * 64 + fr) * D + u.pn * 256 + wc * 32 + 8 * fq;
#pragma unroll
        for (int ai = 0; ai < 2; ++ai)
#pragma unroll
            for (int m = 0; m < 4; ++m) { bf16_t* rowp = base + (size_t)(ai * 128 + m * 16) * D;
#pragma unroll
                for (int bj = 0; bj < 2; ++bj) { const f32x4 v0 = acc[ai][bj][m][0], v1 = acc[ai][bj][m][1]; u32x4 w;
                    w.x = cvt_pk_bf16(v0[0], v0[1]); w.y = cvt_pk_bf16(v0[2], v0[3]); w.z = cvt_pk_bf16(v1[0], v1[1]); w.w = cvt_pk_bf16(v1[2], v1[3]);
                    *(u32x4*)(rowp + bj * 128) = w; } }
    }
};
struct EpiResidH {
    static constexpr bool PERM = false;
    float* x; const float* gvec; const float* bias;
    __device__ __forceinline__ void operator()(const f32x4 (&acc)[2][2][4][2], const Unit& u, int wr, int wc, int fr, int fq) const {
        const int cv = u.pm < 16 ? 0 : 1 + ((u.pm - 16) >> 3);
        const int col0 = u.pn * 128 + wc * 32 + 4 * fq;
        f32x4 g[2], b[2];
#pragma unroll
        for (int n = 0; n < 2; ++n) { g[n] = *(const f32x4*)(gvec + cv * 6144 + col0 + 16 * n); b[n] = bias ? *(const f32x4*)(bias + col0 + 16 * n) : (f32x4){0.f, 0.f, 0.f, 0.f}; }
#pragma unroll
        for (int ai = 0; ai < 2; ++ai)
#pragma unroll
            for (int m = 0; m < 4; ++m) { float* rowp = x + (size_t)(u.pm * 256 + ai * 128 + wr * 64 + m * 16 + fr) * D + col0;
#pragma unroll
                for (int n = 0; n < 2; ++n) { f32x4 xv = *(const f32x4*)(rowp + 16 * n); xv += g[n] * (acc[ai][0][m][n] + b[n]); *(f32x4*)(rowp + 16 * n) = xv; } }
    }
};
struct EpiSeqH {
    static constexpr bool PERM = true;
    bf16_t* f;
    __device__ __forceinline__ void operator()(const f32x4 (&acc)[2][2][4][2], const Unit& u, int wr, int wc, int fr, int fq) const {
        bf16_t* base = f + (size_t)(u.aux + wr * 64 + fr) * D + u.pn * 128 + wc * 32 + 8 * fq;
#pragma unroll
        for (int ai = 0; ai < 2; ++ai)
#pragma unroll
            for (int m = 0; m < 4; ++m) { const f32x4 v0 = acc[ai][0][m][0], v1 = acc[ai][0][m][1]; u32x4 w;
                w.x = cvt_pk_bf16(v0[0], v0[1]); w.y = cvt_pk_bf16(v0[2], v0[3]); w.z = cvt_pk_bf16(v1[0], v1[1]); w.w = cvt_pk_bf16(v1[2], v1[3]);
                *(u32x4*)(base + (size_t)(ai * 128 + m * 16) * D) = w; }
    }
};
struct EpiResid {
    static constexpr bool PERM = true;
    float* x; bf16_t* P; const float* gvec; const float* bias; unsigned* flags;
    __device__ __forceinline__ void operator()(const f32x4 (&acc)[2][2][4][2], const Unit& u, int wr, int wc, int fr, int fq) const {
        unsigned* flag = flags + (u.pm * 4 + u.pn) * 16;
        const size_t off = (size_t)(u.pm * 256 + wr * 64 + fr) * D + u.pn * 256 + wc * 32 + 8 * fq;
        if (u.ks == 1) {
#pragma unroll
            for (int ai = 0; ai < 2; ++ai)
#pragma unroll
                for (int m = 0; m < 4; ++m) { bf16_t* rowp = P + off + (size_t)(ai * 128 + m * 16) * D;
#pragma unroll
                    for (int bj = 0; bj < 2; ++bj) { const f32x4 v0 = acc[ai][bj][m][0], v1 = acc[ai][bj][m][1]; u32x4 w;
                        w.x = cvt_pk_bf16(v0[0], v0[1]); w.y = cvt_pk_bf16(v0[2], v0[3]); w.z = cvt_pk_bf16(v1[0], v1[1]); w.w = cvt_pk_bf16(v1[2], v1[3]);
                        st_wt16(rowp + bj * 128, fq, w); } }
            handoff_publish(flag, fr == 0 && fq == 0);
        } else {
            handoff_wait(flag, 8u);
            const int cv = u.pm < 16 ? 0 : 1 + ((u.pm - 16) >> 3);
            const int col0 = u.pn * 256 + wc * 32 + 8 * fq;
#pragma unroll
            for (int bj = 0; bj < 2; ++bj) {
                const f32x4 g0 = *(const f32x4*)(gvec + cv * 6144 + col0 + bj * 128), g1 = *(const f32x4*)(gvec + cv * 6144 + col0 + bj * 128 + 4);
                f32x4 b0 = {0.f, 0.f, 0.f, 0.f}, b1 = b0;
                if (bias) { b0 = *(const f32x4*)(bias + col0 + bj * 128); b1 = *(const f32x4*)(bias + col0 + bj * 128 + 4); }
#pragma unroll
                for (int ai = 0; ai < 2; ++ai)
#pragma unroll
                    for (int m = 0; m < 4; ++m) { const size_t o = off + (size_t)(ai * 128 + m * 16) * D + bj * 128;
                        const u32x4 pw = ld_ag16(P + o, fq); f32x4 x0 = *(const f32x4*)(x + o), x1 = *(const f32x4*)(x + o + 4);
                        const f32x4 p0 = {bf_lo(pw.x), bf_hi(pw.x), bf_lo(pw.y), bf_hi(pw.y)}, p1 = {bf_lo(pw.z), bf_hi(pw.z), bf_lo(pw.w), bf_hi(pw.w)};
                        x0 += g0 * (acc[ai][bj][m][0] + p0 + b0); x1 += g1 * (acc[ai][bj][m][1] + p1 + b1);
                        *(f32x4*)(x + o) = x0; *(f32x4*)(x + o + 4) = x1; }
            }
        }
    }
};
struct EpiUpRaw {
    static constexpr bool PERM = true;
    bf16_t* out;
    __device__ __forceinline__ void operator()(const f32x4 (&acc)[2][2][4][2], const Unit& u, int wr, int wc, int fr, int fq) const {
        bf16_t* base = out + (size_t)(u.pm * 256 + wr * 64 + fr) * NUP + u.pn * 256 + wc * 32 + 8 * fq;
#pragma unroll
        for (int ai = 0; ai < 2; ++ai)
#pragma unroll
            for (int m = 0; m < 4; ++m) { bf16_t* rowp = base + (size_t)(ai * 128 + m * 16) * NUP;
#pragma unroll
                for (int bj = 0; bj < 2; ++bj) { const f32x4 v0 = acc[ai][bj][m][0], v1 = acc[ai][bj][m][1]; u32x4 w;
                    w.x = cvt_pk_bf16(v0[0], v0[1]); w.y = cvt_pk_bf16(v0[2], v0[3]); w.z = cvt_pk_bf16(v1[0], v1[1]); w.w = cvt_pk_bf16(v1[2], v1[3]);
                    *(u32x4*)(rowp + bj * 128) = w; } }
    }
};
struct EpiChan {
    static constexpr bool PERM = true;
    bf16_t* zt;
    __device__ __forceinline__ void operator()(const f32x4 (&acc)[2][2][4][2], const Unit& u, int wr, int wc, int fr, int fq) const {
        const int T = u.pn, cs = u.pm, grp = u.aux; size_t rowstart;
        if (T < 16) rowstart = (size_t)(T >> 3) * 1024 * 4096 + (T & 7) * 512 + cs * 256;
        else { const int b = (T - 16) >> 3, tq = (T - 16) & 7; rowstart = (size_t)(2 + b) * 1024 * 4096 + cs * 2048 + tq * 256; }
        bf16_t* base = zt + rowstart + (size_t)(grp * 256 + wr * 64 + fr) * 4096 + wc * 32 + 8 * fq;
#pragma unroll
        for (int ai = 0; ai < 2; ++ai)
#pragma unroll
            for (int m = 0; m < 4; ++m) { bf16_t* rowp = base + (size_t)(ai * 128 + m * 16) * 4096;
#pragma unroll
                for (int bj = 0; bj < 2; ++bj) { const f32x4 v0 = acc[ai][bj][m][0], v1 = acc[ai][bj][m][1]; u32x4 w;
                    w.x = cvt_pk_bf16(v0[0], v0[1]); w.y = cvt_pk_bf16(v0[2], v0[3]); w.z = cvt_pk_bf16(v1[0], v1[1]); w.w = cvt_pk_bf16(v1[2], v1[3]);
                    *(u32x4*)(rowp + bj * 128) = w; } }
    }
};
struct EpiSeq {
    static constexpr bool PERM = true;
    bf16_t* f; bf16_t* P; unsigned* flags;
    __device__ __forceinline__ void operator()(const f32x4 (&acc)[2][2][4][2], const Unit& u, int wr, int wc, int fr, int fq) const {
        const size_t rowoff = (size_t)(wr * 64 + fr) * D + u.pn * 256 + wc * 32 + 8 * fq;
        if (u.ks > 0) {
            bf16_t* base = P + (size_t)(u.ks - 1) * 4096 * D + (size_t)(u.aux - 4096) * D + rowoff;
#pragma unroll
            for (int ai = 0; ai < 2; ++ai)
#pragma unroll
                for (int m = 0; m < 4; ++m) { bf16_t* rowp = base + (size_t)(ai * 128 + m * 16) * D;
#pragma unroll
                    for (int bj = 0; bj < 2; ++bj) { const f32x4 v0 = acc[ai][bj][m][0], v1 = acc[ai][bj][m][1]; u32x4 w;
                        w.x = cvt_pk_bf16(v0[0], v0[1]); w.y = cvt_pk_bf16(v0[2], v0[3]); w.z = cvt_pk_bf16(v1[0], v1[1]); w.w = cvt_pk_bf16(v1[2], v1[3]);
                        st_wt16(rowp + bj * 128, fq, w); } }
            handoff_publish(flags + u.pm * 16, fr == 0 && fq == 0);
        } else {
            if (u.ks == 0) handoff_wait(flags + u.pm * 16, 24u);
            bf16_t* base = f + (size_t)u.aux * D + rowoff; const bf16_t* pb = P + (size_t)(u.ks == 0 ? u.aux - 4096 : 0) * D + rowoff;
#pragma unroll
            for (int ai = 0; ai < 2; ++ai)
#pragma unroll
                for (int m = 0; m < 4; ++m) { const size_t ro = (size_t)(ai * 128 + m * 16) * D;
#pragma unroll
                    for (int bj = 0; bj < 2; ++bj) { f32x4 v0 = acc[ai][bj][m][0], v1 = acc[ai][bj][m][1];
                        if (u.ks == 0) {
#pragma unroll
                            for (int q = 0; q < 3; ++q) { const u32x4 pw = ld_ag16(pb + (size_t)q * 4096 * D + ro + bj * 128, fq);
                                v0 += (f32x4){bf_lo(pw.x), bf_hi(pw.x), bf_lo(pw.y), bf_hi(pw.y)}; v1 += (f32x4){bf_lo(pw.z), bf_hi(pw.z), bf_lo(pw.w), bf_hi(pw.w)}; } }
                        u32x4 w; w.x = cvt_pk_bf16(v0[0], v0[1]); w.y = cvt_pk_bf16(v0[2], v0[3]); w.z = cvt_pk_bf16(v1[0], v1[1]); w.w = cvt_pk_bf16(v1[2], v1[3]);
                        *(u32x4*)(base + ro + bj * 128) = w; } }
        }
    }
};

template <int CTRL> __device__ __forceinline__ float dpp_f(float old, float src) { return __int_as_float(__builtin_amdgcn_update_dpp(__float_as_int(old), __float_as_int(src), CTRL, 0xf, 0xf, false)); }
struct EpiUpConv {
    static constexpr bool PERM = true;
    bf16_t* act; const float* cw; const float* cb; LAS unsigned char* xl;
    __device__ __forceinline__ void operator()(const f32x4 (&acc)[2][2][4][2], const Unit& u, int wr, int wc, int fr, int fq) const {
        asm volatile("" : "+v"(fr), "+v"(fq));
        const bool ctx = u.pm < 16; const int w = wr * 4 + wc, w2 = (wr ^ 1) * 4 + wc;
        LAS unsigned char* xw = xl + w * 1024 + fq * 16;
        LAS unsigned char* xp = xl + w2 * 1024 + fq * 16 + (wr - 1) * 512;
        LAS unsigned char* xn = xl + w2 * 1024 + fq * 16 + wr * 512;
        if (ctx) {
            if (fr == 0 || fr == 15) { const bool first = fr == 0; LAS unsigned char* xq = xw + (first ? 0 : 256);
#pragma unroll
                for (int ai = 0; ai < 2; ++ai)
#pragma unroll
                    for (int bj = 0; bj < 2; ++bj)
#pragma unroll
                        for (int n = 0; n < 2; ++n) { f32x4 v;
#pragma unroll
                            for (int q = 0; q < 4; ++q) v[q] = first ? acc[ai][bj][0][n][q] : acc[ai][bj][3][n][q];
                            *(LAS f32x4*)(xq + ai * 512 + bj * 128 + n * 64) = v; }
            }
            asm volatile("s_waitcnt lgkmcnt(0)" ::: "memory"); __builtin_amdgcn_s_barrier(); asm volatile("" ::: "memory");
        }
        const int ch0 = u.pn * 128 + wc * 32 + 8 * fq;
        bf16_t* obase = act + (size_t)(u.pm * 256 + wr * 64 + fr) * DFF + ch0;
#pragma unroll
        for (int n = 0; n < 2; ++n) {
            const int cg = ch0 + 4 * n, cvl = DFF + ch0 + 4 * n;
            const f32x4 wg0 = *(const f32x4*)(cw + cg), wg1 = *(const f32x4*)(cw + NUP + cg), wg2 = *(const f32x4*)(cw + 2 * NUP + cg), bg = *(const f32x4*)(cb + cg);
            const f32x4 wv0 = *(const f32x4*)(cw + cvl), wv1 = *(const f32x4*)(cw + NUP + cvl), wv2 = *(const f32x4*)(cw + 2 * NUP + cvl), bv = *(const f32x4*)(cb + cvl);
#pragma unroll
            for (int ai = 0; ai < 2; ++ai) {
                const bool hasp = ctx && (ai == 1 || wr == 1), hasn = ctx && (ai == 0 || wr == 0);
                const f32x4 z4 = {0.f, 0.f, 0.f, 0.f};
                f32x4 pg = *(const LAS f32x4*)(xp + ai * 512 + 256 + 0 * 128 + n * 64), pv = *(const LAS f32x4*)(xp + ai * 512 + 256 + 1 * 128 + n * 64);
                f32x4 ng = *(const LAS f32x4*)(xn + ai * 512 + 0 * 128 + n * 64), nv = *(const LAS f32x4*)(xn + ai * 512 + 1 * 128 + n * 64);
                pg = hasp ? pg : z4; pv = hasp ? pv : z4; ng = hasn ? ng : z4; nv = hasn ? nv : z4;
#pragma unroll
                for (int m = 0; m < 4; ++m) { float res[4];
#pragma unroll
                    for (int q = 0; q < 4; ++q) {
                        const float cgv = acc[ai][0][m][n][q], cvv = acc[ai][1][m][n][q];
                        const float opg = (m == 0) ? pg[q] : dpp_f<0x121>(0.f, acc[ai][0][m == 0 ? 0 : m - 1][n][q]);
                        const float opv = (m == 0) ? pv[q] : dpp_f<0x121>(0.f, acc[ai][1][m == 0 ? 0 : m - 1][n][q]);
                        const float ong = (m == 3) ? ng[q] : dpp_f<0x12F>(0.f, acc[ai][0][m == 3 ? 3 : m + 1][n][q]);
                        const float onv = (m == 3) ? nv[q] : dpp_f<0x12F>(0.f, acc[ai][1][m == 3 ? 3 : m + 1][n][q]);
                        const float prg = dpp_f<0x111>(opg, cgv), prv = dpp_f<0x111>(opv, cvv);
                        const float nxg = dpp_f<0x101>(ong, cgv), nxv = dpp_f<0x101>(onv, cvv);
                        const float G = __builtin_fmaf(wg0[q], prg, __builtin_fmaf(wg1[q], cgv, __builtin_fmaf(wg2[q], nxg, bg[q])));
                        const float V = __builtin_fmaf(wv0[q], prv, __builtin_fmaf(wv1[q], cvv, __builtin_fmaf(wv2[q], nxv, bv[q])));
                        res[q] = G * sigmoidf_(G) * V; }
                    u32x2 o; o.x = cvt_pk_bf16(res[0], res[1]); o.y = cvt_pk_bf16(res[2], res[3]);
                    *(u32x2*)(obase + (size_t)(ai * 128 + m * 16) * DFF + 4 * n) = o; }
                __builtin_amdgcn_sched_barrier(0);
            }
        }
    }
};

constexpr size_t WS_CTL = 512 * 1024, CTL_BYTES = 16384;
constexpr int FL_WF = 4096, FL_DN = FL_WF + 2 * 2048, FL_SQ = FL_DN + 4 * 2048;
constexpr int MISC_OFF = LDS_BYTES - 64;
#define XB_TMO      128
#define XB_XCNT(j)  (256  + 64 * (j))
#define XB_XSUB(j)  (1280 + 64 * (j))
#define XB_XGEN(j)  (2304 + 64 * (j))
#define XB_TOP      3328
#define XB_TOPGEN   3392
#define XCD_BAR_WORDS 3456
#define XB_SPIN_CAP (1u << 18)

__device__ __forceinline__ unsigned xb_ld(unsigned* p)              { return __hip_atomic_load(p, __ATOMIC_RELAXED, __HIP_MEMORY_SCOPE_AGENT); }
__device__ __forceinline__ unsigned xb_add(unsigned* p, unsigned v) { return __hip_atomic_fetch_add(p, v, __ATOMIC_RELAXED, __HIP_MEMORY_SCOPE_AGENT); }
__device__ __forceinline__ unsigned xb_xcc_id() { return (unsigned)__builtin_amdgcn_s_getreg((3 << 11) | 20) & 0xFu; }
#define XB_SPIN(cond, bar) do { unsigned _sp = 0; while (cond) { \
    if ((++_sp & 255u) == 0u) { if (xb_ld(&(bar)[XB_TMO])) break; if (_sp > XB_SPIN_CAP) { atomicAdd(&(bar)[XB_TMO], 1u); break; } } } } while (0)

struct XcdBarrier {
    unsigned* bar; unsigned x;
    volatile LAS unsigned* st;
};

__device__ __forceinline__ XcdBarrier xcd_barrier_post(unsigned* bar, volatile LAS unsigned* st, const bool t0) {
    XcdBarrier b; b.bar = bar; b.x = xb_xcc_id(); b.st = st;
    if (t0) (void)xb_add(&bar[XB_XCNT(b.x)], 1u);
    return b;
}
__device__ __forceinline__ void xcd_barrier_complete(unsigned* bar, unsigned x, unsigned& nloc, unsigned& nx) {
    const unsigned G = gridDim.x * gridDim.y * gridDim.z;
    unsigned sum, cnt, mine, sp = 0u;
    for (;;) {
        sum = 0u; cnt = 0u; mine = 0u;
#pragma unroll
        for (unsigned j = 0; j < 16; ++j) { const unsigned c = xb_ld(&bar[XB_XCNT(j)]); sum += c; cnt += (c > 0u) ? 1u : 0u; mine = (j == x) ? c : mine; }
        if (sum == G) break;
        __builtin_amdgcn_s_sleep(1);
        if ((++sp & 255u) == 0u) { if (xb_ld(&bar[XB_TMO])) break; if (sp > XB_SPIN_CAP) { atomicAdd(&bar[XB_TMO], 1u); break; } }
    }
    nloc = mine > 0u ? mine : 1u; nx = cnt > 0u ? cnt : 1u;
}

__device__ __forceinline__ void xcd_barrier(const XcdBarrier& b, const bool t0) {
    asm volatile("s_waitcnt vmcnt(0)" ::: "memory");
    __syncthreads();
    if (t0) {
        unsigned* bar = b.bar;
        __builtin_amdgcn_s_waitcnt(0);
        unsigned nloc = b.st[0], nx = b.st[1];
        if (nloc == 0u) { xcd_barrier_complete(bar, b.x, nloc, nx); b.st[0] = nloc; b.st[1] = nx; }
        const unsigned old = xb_add(&bar[XB_XSUB(b.x)], 1u);
        const unsigned gen = old / nloc;
        if (old + 1u == (gen + 1u) * nloc) {
            __builtin_amdgcn_fence(__ATOMIC_RELEASE, "agent");
            asm volatile("s_waitcnt vmcnt(0)" ::: "memory");
            const unsigned og = xb_add(&bar[XB_TOP], 1u);
            const unsigned tg = og / nx;
            if (og + 1u == (tg + 1u) * nx) xb_add(&bar[XB_TOPGEN], 1u);
            else XB_SPIN(xb_ld(&bar[XB_TOPGEN]) == tg, bar);
            __builtin_amdgcn_fence(__ATOMIC_ACQUIRE, "agent");
            xb_add(&bar[XB_XGEN(b.x)], 1u);
            asm volatile("s_waitcnt vmcnt(0)" ::: "memory");
        } else {
            XB_SPIN(xb_ld(&bar[XB_XGEN(b.x)]) == gen, bar);
            __builtin_amdgcn_fence(__ATOMIC_ACQUIRE, "agent");
            asm volatile("s_waitcnt vmcnt(0)" ::: "memory");
        }
    }
    __syncthreads();
}


__device__ __forceinline__ void transpose_item(const float* W, int K, int N, bf16_t* WT, int H, LAS float* scr, int item, int lane) {
    const int nblk = N / 32, kb = item / nblk, nb = item % nblk, k0 = 64 * kb, n0 = 32 * nb;
    int d0 = n0;
    if (H > 0) d0 = (n0 < H) ? (256 * (n0 / 128) + (n0 % 128)) : (256 * ((n0 - H) / 128) + 128 + ((n0 - H) % 128));
    float v[32];
    const float* wp = W + (size_t)(k0 + (lane >> 5)) * N + n0 + (lane & 31);
#pragma unroll
    for (int i = 0; i < 32; ++i) v[i] = __builtin_nontemporal_load(wp + (size_t)(2 * i) * N);
#pragma unroll
    for (int i = 0; i < 32; ++i) scr[(2 * i + (lane >> 5)) * 33 + (lane & 31)] = v[i];
    asm volatile("s_waitcnt lgkmcnt(0)" ::: "memory");
    const int c = lane & 7;
#pragma unroll
    for (int j = 0; j < 4; ++j) { const int n = (lane >> 3) + 8 * j; const LAS float* s = scr + (8 * c) * 33 + n;
        u32x4 o; o.x = cvt_pk_bf16(s[0 * 33], s[1 * 33]); o.y = cvt_pk_bf16(s[2 * 33], s[3 * 33]); o.z = cvt_pk_bf16(s[4 * 33], s[5 * 33]); o.w = cvt_pk_bf16(s[6 * 33], s[7 * 33]);
        *(u32x4*)(WT + (size_t)(d0 + n) * K + k0 + 8 * c) = o; }
    asm volatile("s_waitcnt lgkmcnt(0)" ::: "memory");
}

constexpr int I_GLU = 16 * 64, I_F = 16 * 32, I_UP = 16 * 176, I_DN = 44 * 32;
__device__ __forceinline__ void convert_updown_item(const Params& p, int i, int r, LAS float* scr, int lane) {
    if (r < I_UP) transpose_item(p.w_up + (size_t)i * 1024 * NUP, 1024, NUP, (bf16_t*)(p.ws + WS_WUP) + (size_t)i * NUP * 1024, DFF, scr, r, lane);
    else transpose_item(p.w_down + (size_t)i * DFF * 1024, DFF, 1024, (bf16_t*)(p.ws + WS_WDN) + (size_t)i * 1024 * DFF, 0, scr, r - I_UP, lane);
}
__device__ __forceinline__ void phase_prep(const Params& p, const int tid, LAS unsigned char* lds) {
    const int lane = tid & 63, w = tid >> 6, G = gridDim.x;
    unsigned char* ws = p.ws;
    LAS float* scond = (LAS float*)lds;
    LAS float* red = (LAS float*)(lds + 12288);
    float* mod = (float*)(ws + WS_MOD);
    if (blockIdx.x < 192) {
        for (int q = tid; q < 3072; q += NTHREADS) { const int cv = q >> 10, k = q & 1023; const float v = cv == 0 ? p.c_ctx[k] : p.c[(cv - 1) * 1024 + k]; scond[q] = v * sigmoidf_(v); }
        __syncthreads();
        for (int it = blockIdx.x; it < 192; it += G) {
            const int i = it / 48, n0 = (it % 48) * 128;
            const float* wp = p.w_ada + ((size_t)i * 1024 + w * 128) * 6144 + n0 + 2 * lane;
            float a00 = 0.f, a01 = 0.f, a10 = 0.f, a11 = 0.f, a20 = 0.f, a21 = 0.f;
#pragma unroll 32
            for (int k = 0; k < 128; ++k) { const f32x2 wv = __builtin_nontemporal_load((const f32x2*)(wp + (size_t)k * 6144)); const int kk = w * 128 + k;
                const float s0 = scond[kk], s1 = scond[1024 + kk], s2 = scond[2048 + kk];
                a00 += s0 * wv.x; a01 += s0 * wv.y; a10 += s1 * wv.x; a11 += s1 * wv.y; a20 += s2 * wv.x; a21 += s2 * wv.y; }
            LAS float* r = red + (w * 64 + lane) * 6; r[0] = a00; r[1] = a01; r[2] = a10; r[3] = a11; r[4] = a20; r[5] = a21;
            __syncthreads();
            if (tid < 384) { const int l = tid / 6, e = tid % 6; float s = 0.f;
#pragma unroll
                for (int ww = 0; ww < 8; ++ww) s += red[(ww * 64 + l) * 6 + e];
                const int cv = e >> 1, n = n0 + 2 * l + (e & 1); mod[((size_t)i * 3 + cv) * 6144 + n] = s + p.b_ada[i * 6144 + n]; }
            __syncthreads();
        }
    }
    __syncthreads();
    {
        LAS float* scr = (LAS float*)(lds + 32768 + w * 8704);
        const int rb = (blockIdx.x + G - (192 % G)) % G;
        const int gw = rb * 8 + w, NGW = G * 8;
        constexpr int NITEMS = 2 * I_GLU + 2 * I_F + I_UP + I_DN;
        for (int it = gw; it < NITEMS; it += NGW) {
            int r = it;
            if (r < 2 * I_GLU) { const int j = r / I_GLU; transpose_item(p.w_glu + (size_t)j * 1024 * 2048, 1024, 2048, (bf16_t*)(ws + WS_WGLU) + (size_t)j * 2048 * 1024, 1024, scr, r % I_GLU, lane); continue; } r -= 2 * I_GLU;
            if (r < 2 * I_F) { const int j = r / I_F; transpose_item(p.w_fourier + (size_t)j * 1024 * 1024, 1024, 1024, (bf16_t*)(ws + WS_WF) + (size_t)j * 1024 * 1024, 0, scr, r % I_F, lane); continue; } r -= 2 * I_F;
            convert_updown_item(p, 0, r, scr, lane);
        }
    }
    {
        const int gt = blockIdx.x * NTHREADS + tid, NT = G * NTHREADS;
        bf16_t* al2048 = (bf16_t*)(ws + WS_AL2048);
        const float s2048 = 0.022097086912079608f;
        for (int q = gt; q < 2048 * 512; q += NT) { const int k1 = q >> 9, k0 = (q & 511) * 8; float v[8];
#pragma unroll
            for (int e = 0; e < 8; ++e) { const int k = k0 + e, n1 = k & 2047; const int idx = (k1 * n1) & 2047; const float rv = (float)idx * (1.0f / 2048.0f); v[e] = (k < 2048 ? __builtin_amdgcn_cosf(rv) : -__builtin_amdgcn_sinf(rv)) * s2048; }
            u32x4 o; o.x = cvt_pk_bf16(v[0], v[1]); o.y = cvt_pk_bf16(v[2], v[3]); o.z = cvt_pk_bf16(v[4], v[5]); o.w = cvt_pk_bf16(v[6], v[7]);
            *(u32x4*)(al2048 + (size_t)k1 * 4096 + k0) = o; }
        bf16_t* al256 = (bf16_t*)(ws + WS_AL256);
        for (int q = gt; q < 256 * 64; q += NT) { const int k1 = q >> 6, k0 = (q & 63) * 8; float v[8];
#pragma unroll
            for (int e = 0; e < 8; ++e) { const int k = k0 + e, n1 = k & 255; const int idx = (k1 * n1) & 255; const float rv = (float)idx * (1.0f / 256.0f); v[e] = (k < 256 ? __builtin_amdgcn_cosf(rv) : -__builtin_amdgcn_sinf(rv)) * 0.0625f; }
            u32x4 o; o.x = cvt_pk_bf16(v[0], v[1]); o.y = cvt_pk_bf16(v[2], v[3]); o.z = cvt_pk_bf16(v[4], v[5]); o.w = cvt_pk_bf16(v[6], v[7]);
            *(u32x4*)(al256 + (size_t)k1 * 4096 + k0) = o; }
        bf16_t* dftc = (bf16_t*)(ws + WS_DFTC);
        for (int q = gt; q < 512 * 32; q += NT) { const int r = q >> 5, k0 = (q & 31) * 8; float v[8];
#pragma unroll
            for (int e = 0; e < 8; ++e) { const int n = k0 + e; const int idx = ((r & 255) * n) & 255; const float rv = (float)idx * (1.0f / 256.0f); v[e] = (r < 256 ? __builtin_amdgcn_cosf(rv) : __builtin_amdgcn_sinf(rv)) * 0.0625f; }
            u32x4 o; o.x = cvt_pk_bf16(v[0], v[1]); o.y = cvt_pk_bf16(v[2], v[3]); o.z = cvt_pk_bf16(v[4], v[5]); o.w = cvt_pk_bf16(v[6], v[7]);
            *(u32x4*)(dftc + (size_t)r * 256 + k0) = o; }
        bf16_t* Bm = (bf16_t*)(ws + WS_BM); bf16_t* Cm = (bf16_t*)(ws + WS_CM); float* AB = (float*)(ws + WS_AB); float* A128 = (float*)(ws + WS_A128);
        for (int q = gt; q < 4 * 64 * 64; q += NT) { const int pp = q & 63, g = (q >> 6) & 63, jd = q >> 12;
            const float dt = expf(p.log_dt[jd * 64 + g]); const float lr = p.lam_re[q], li = p.lam_im[q];
            const float ea = lr * dt, eb = li * dt; const float er = expf(ea); float sn, cs; sincosf(eb, &sn, &cs); const float ar = er * cs, ai = er * sn;
            float snh, csh; sincosf(0.5f * eb, &snh, &csh);
            const float dr = expm1f(ea) * cs - 2.0f * snh * snh, di = ai;
            const float den = lr * lr + li * li; const float cr = (dr * lr + di * li) / den, ci = (di * lr - dr * li) / den;
            const float e128 = expf(128.0f * ea); float sn2, cs2; sincosf(128.0f * eb, &sn2, &cs2);
            AB[q * 2] = ar; AB[q * 2 + 1] = ai; A128[q * 2] = e128 * cs2; A128[q * 2 + 1] = e128 * sn2;
            float vr[16], vi[16];
#pragma unroll
            for (int cc = 0; cc < 16; ++cc) { const float br = p.b_re[(size_t)q * 16 + cc], bi = p.b_im[(size_t)q * 16 + cc]; vr[cc] = cr * br - ci * bi; vi[cc] = cr * bi + ci * br; }
            bf16_t* brow = Bm + ((size_t)(jd * 64 + g) * 128 + pp) * 16; bf16_t* irow = brow + 64 * 16;
#pragma unroll
            for (int h = 0; h < 2; ++h) { u32x4 o; o.x = cvt_pk_bf16(vr[8 * h], vr[8 * h + 1]); o.y = cvt_pk_bf16(vr[8 * h + 2], vr[8 * h + 3]); o.z = cvt_pk_bf16(vr[8 * h + 4], vr[8 * h + 5]); o.w = cvt_pk_bf16(vr[8 * h + 6], vr[8 * h + 7]); *(u32x4*)(brow + 8 * h) = o;
                u32x4 o2; o2.x = cvt_pk_bf16(vi[8 * h], vi[8 * h + 1]); o2.y = cvt_pk_bf16(vi[8 * h + 2], vi[8 * h + 3]); o2.z = cvt_pk_bf16(vi[8 * h + 4], vi[8 * h + 5]); o2.w = cvt_pk_bf16(vi[8 * h + 6], vi[8 * h + 7]); *(u32x4*)(irow + 8 * h) = o2; }
#pragma unroll
            for (int cc = 0; cc < 16; ++cc) { const size_t ci2 = ((size_t)(jd * 64 + g) * 16 + cc) * 64 + pp; *(unsigned*)(Cm + ((size_t)(jd * 64 + g) * 16 + cc) * 128 + 2 * pp) = cvt_pk_bf16(p.c_re[ci2], -p.c_im[ci2]); }
        }
    }
}

template <int MODE>
__device__ __forceinline__ void phase_norm(const Params& p, const int tid, bool first, bool pend, const float* gP  , const float* bP  , const float* gn, const float* sc, const float* sh) {
    const int lane = tid & 63, w = tid >> 6, G = gridDim.x;
    float* X = (float*)(p.ws + WS_X); bf16_t* H = (bf16_t*)(p.ws + WS_H);
    constexpr int R = 4;
    const int rstride = G * 8;
    for (int base = blockIdx.x * 8 + w; base < NTOK; base += rstride * R) {
        f32x4 v[R][4];
#pragma unroll
        for (int k = 0; k < R; ++k) { const int m = base + k * rstride; if (m < NTOK) {
            const float* src = first ? (m < 4096 ? p.x_prompt + (size_t)m * D : p.x_sample + (size_t)(m - 4096) * D) : X + (size_t)m * D;
#pragma unroll
            for (int j = 0; j < 2; ++j) { v[k][2 * j] = *(const f32x4*)(src + lane * 8 + 512 * j); v[k][2 * j + 1] = *(const f32x4*)(src + lane * 8 + 512 * j + 4); } } }
#pragma unroll
        for (int k = 0; k < R; ++k) { const int m = base + k * rstride; if (m < NTOK) { const int cv = cond_of_row(m);
            if (MODE == 0 && first) {
#pragma unroll
                for (int j = 0; j < 2; ++j) { *(f32x4*)(X + (size_t)m * D + lane * 8 + 512 * j) = v[k][2 * j]; *(f32x4*)(X + (size_t)m * D + lane * 8 + 512 * j + 4) = v[k][2 * j + 1]; }
            }
            float ss = 0.f;
#pragma unroll
            for (int j = 0; j < 4; ++j) ss += (v[k][j].x * v[k][j].x + v[k][j].y * v[k][j].y) + (v[k][j].z * v[k][j].z + v[k][j].w * v[k][j].w);
            ss = wave_sum(ss, lane);
            const float rstd = 1.0f / sqrtf(ss * (1.0f / 1024.0f) + 1e-6f);
#pragma unroll
            for (int j = 0; j < 2; ++j) { const int col = lane * 8 + 512 * j;
                if (MODE == 0) { u32x4 pk;
#pragma unroll
                    for (int hlf = 0; hlf < 2; ++hlf) { const int c4 = col + 4 * hlf; const f32x4 g = *(const f32x4*)(gn + c4), s1 = *(const f32x4*)(sc + cv * 6144 + c4), s0 = *(const f32x4*)(sh + cv * 6144 + c4); f32x4 o;
#pragma unroll
                        for (int q = 0; q < 4; ++q) o[q] = v[k][2 * j + hlf][q] * rstd * g[q] * (1.0f + s1[q]) + s0[q];
                        if (hlf == 0) { pk.x = cvt_pk_bf16(o[0], o[1]); pk.y = cvt_pk_bf16(o[2], o[3]); } else { pk.z = cvt_pk_bf16(o[0], o[1]); pk.w = cvt_pk_bf16(o[2], o[3]); } }
                    *(u32x4*)(H + (size_t)m * D + col) = pk; }
                else {
#pragma unroll
                    for (int hlf = 0; hlf < 2; ++hlf) { const int c4 = col + 4 * hlf; const f32x4 g = *(const f32x4*)(gn + c4); f32x4 o;
#pragma unroll
                        for (int q = 0; q < 4; ++q) o[q] = v[k][2 * j + hlf][q] * rstd * g[q];
                        *(f32x4*)(p.out + (size_t)m * D + c4) = o; } }
            } } }
    }
}

constexpr int HT_STRIDE = 272;
constexpr int HT_BYTES = 256 * HT_STRIDE;
constexpr int HB_BYTES = 32 * HT_STRIDE;

template <bool P2, int DIR>
__device__ __forceinline__ void s5_dir(const Params& p, int j, int T, int g, int w, int lane, LAS unsigned char* hT, LAS unsigned char* hb, f32x4 (&yacc)[16]) {
    const int n = lane & 31, hh = lane >> 5, jd = j * 2 + DIR;
    const bf16_t* Bm = (const bf16_t*)(p.ws + WS_BM) + (size_t)(jd * 64 + g) * 128 * 16;
    const float* AB = (const float*)(p.ws + WS_AB) + (size_t)(jd * 64 + g) * 128;
    bf16x8 bfr[4];
#pragma unroll
    for (int nb = 0; nb < 4; ++nb) bfr[nb] = *(const bf16x8*)(Bm + (nb * 32 + n) * 16 + hh * 8);
    const float a0r = AB[2 * n], a0i = AB[2 * n + 1], a1r = AB[2 * (32 + n)], a1i = AB[2 * (32 + n) + 1];
    float h0r = 0.f, h0i = 0.f, h1r = 0.f, h1i = 0.f;
    const int sc = 2 * T + hh;
    bf16x8 cfr[4];
    if constexpr (P2) {
        const bf16_t* Cm = (const bf16_t*)(p.ws + WS_CM) + (size_t)(jd * 64 + g) * 16 * 128;
#pragma unroll
        for (int ks = 0; ks < 4; ++ks) cfr[ks] = *(const bf16x8*)(Cm + (lane & 15) * 128 + ks * 32 + (lane >> 4) * 8);
        const float* A128 = (const float*)(p.ws + WS_A128) + (size_t)(jd * 64 + g) * 128;
        const float b0r = A128[2 * n], b0i = A128[2 * n + 1], b1r = A128[2 * (32 + n)], b1i = A128[2 * (32 + n) + 1];
        int sc0, nsc;
        if (T < 16) { sc0 = 2 * T; nsc = 2; }
        else { const int bs = (T - 16) >> 3; sc0 = 32 + 16 * bs; nsc = 16; const size_t si = (size_t)((bs * 2 + j) * 2 + DIR) * 4096 + g * 64;
            h0r = p.st_re[si + n]; h0i = p.st_im[si + n]; h1r = p.st_re[si + 32 + n]; h1i = p.st_im[si + 32 + n]; }
        const float* Sb = (const float*)(p.ws + WS_S) + (size_t)DIR * 64 * 64 * 128 + (size_t)g * 128;
        if (T >= 16) {
            f32x2 s0[15], s1[15];
#pragma unroll
            for (int e = 0; e < 15; ++e) { const int q = DIR == 0 ? sc0 + e : sc0 + 15 - e; const bool ok = DIR == 0 ? q < sc : q > sc;
                const float* sp = Sb + (size_t)(ok ? q : sc) * 64 * 128; s0[e] = *(const f32x2*)(sp + 2 * n); s1[e] = *(const f32x2*)(sp + 2 * (32 + n)); }
#pragma unroll
            for (int e = 0; e < 15; ++e) { const int q = DIR == 0 ? sc0 + e : sc0 + 15 - e; const bool ok = DIR == 0 ? q < sc : q > sc;
                const float t0 = b0r * h0r - b0i * h0i + s0[e].x, t1 = b0r * h0i + b0i * h0r + s0[e].y, t2 = b1r * h1r - b1i * h1i + s1[e].x, t3 = b1r * h1i + b1i * h1r + s1[e].y;
                h0r = ok ? t0 : h0r; h0i = ok ? t1 : h0i; h1r = ok ? t2 : h1r; h1i = ok ? t3 : h1i; }
        } else if ((DIR == 0) == (hh == 1)) {
            const float* sp = Sb + (size_t)(DIR == 0 ? sc0 : sc0 + 1) * 64 * 128; const f32x2 s0 = *(const f32x2*)(sp + 2 * n), s1 = *(const f32x2*)(sp + 2 * (32 + n));
            const float t0 = b0r * h0r - b0i * h0i + s0.x, t1 = b0r * h0i + b0i * h0r + s0.y, t2 = b1r * h1r - b1i * h1i + s1.x, t3 = b1r * h1i + b1i * h1r + s1.y;
            h0r = t0; h0i = t1; h1r = t2; h1i = t3;
        }
    }
    const f32x16 zero16 = {0.f, 0.f, 0.f, 0.f, 0.f, 0.f, 0.f, 0.f, 0.f, 0.f, 0.f, 0.f, 0.f, 0.f, 0.f, 0.f};
#pragma unroll
    for (int bi = 0; bi < 8; ++bi) {
        const int blk = DIR ? 7 - bi : bi;
        const int tokrow = 128 * ((n >> 2) & 1) + 16 * blk + 4 * (n >> 3) + (n & 3);
        const bf16x8 af = *(const LAS bf16x8*)(hT + tokrow * HT_STRIDE + w * 32 + hh * 16);
#pragma unroll
        for (int sh = 0; sh < 2; ++sh) {
            f32x16 br = __builtin_amdgcn_mfma_f32_32x32x16_bf16(af, bfr[sh], zero16, 0, 0, 0);
            f32x16 bim = __builtin_amdgcn_mfma_f32_32x32x16_bf16(af, bfr[2 + sh], zero16, 0, 0, 0);
            const float ar = sh ? a1r : a0r, ai = sh ? a1i : a0i;
            float hr = sh ? h1r : h0r, hi = sh ? h1i : h0i;
#pragma unroll
            for (int rr = 0; rr < 16; ++rr) { const int r = DIR ? 15 - rr : rr;
                const float t0 = __builtin_fmaf(ar, hr, __builtin_fmaf(-ai, hi, br[r])), t1 = __builtin_fmaf(ar, hi, __builtin_fmaf(ai, hr, bim[r])); hr = t0; hi = t1; br[r] = t0; bim[r] = t1; }
            if (sh) { h1r = hr; h1i = hi; } else { h0r = hr; h0i = hi; }
            if constexpr (P2) {
                if (bi == 0 && T < 16 && hh == DIR) {
                    const int r = DIR ? 15 : 0; const size_t oi = (size_t)((T * 2 + j) * 2 + DIR) * 4096 + g * 64 + sh * 32 + n;
                    float* ore = p.out + (size_t)NTOK * D; float* oim = ore + 16 * 2 * 2 * 4096;
                    ore[oi] = br[r]; oim[oi] = bim[r]; }
#pragma unroll
                for (int r = 0; r < 16; ++r) *(LAS unsigned*)(hb + (hh * 16 + r) * HT_STRIDE + (sh * 32 + n) * 4) = cvt_pk_bf16(br[r], bim[r]);
            }
        }
        if constexpr (P2) {
#pragma unroll
            for (int hs = 0; hs < 2; ++hs)
#pragma unroll
                for (int ks = 0; ks < 4; ++ks) { const bf16x8 hf = *(const LAS bf16x8*)(hb + (hs * 16 + (lane & 15)) * HT_STRIDE + ks * 64 + (lane >> 4) * 16);
                    yacc[hs * 8 + blk] = __builtin_amdgcn_mfma_f32_16x16x32_bf16(cfr[ks], hf, yacc[hs * 8 + blk], 0, 0, 0); }
            __builtin_amdgcn_sched_barrier(0);
        }
    }
    if constexpr (!P2) {
        float* So = (float*)(p.ws + WS_S) + ((size_t)(DIR * 64 + sc) * 64 + g) * 128;
        *(f32x2*)(So + 2 * n) = (f32x2){h0r, h0i}; *(f32x2*)(So + 2 * (32 + n)) = (f32x2){h1r, h1i};
    }
}

__device__ __forceinline__ void s5_pass1_item(const Params& p, int j, int T, int g, int w, int lane, LAS unsigned char* hT) {
    const int n = lane & 31, hh = lane >> 5, sc = 2 * T + hh;
    bf16x8 bfr[2][4]; float ar[2][2], ai[2][2], hr[2][2], hi[2][2];
#pragma unroll
    for (int d = 0; d < 2; ++d) { const int jd = j * 2 + d;
        const bf16_t* Bm = (const bf16_t*)(p.ws + WS_BM) + (size_t)(jd * 64 + g) * 128 * 16; const float* AB = (const float*)(p.ws + WS_AB) + (size_t)(jd * 64 + g) * 128;
#pragma unroll
        for (int nb = 0; nb < 4; ++nb) bfr[d][nb] = *(const bf16x8*)(Bm + (nb * 32 + n) * 16 + hh * 8);
#pragma unroll
        for (int sh = 0; sh < 2; ++sh) { ar[d][sh] = AB[2 * (sh * 32 + n)]; ai[d][sh] = AB[2 * (sh * 32 + n) + 1]; hr[d][sh] = 0.f; hi[d][sh] = 0.f; } }
    const f32x16 zero16 = {0.f, 0.f, 0.f, 0.f, 0.f, 0.f, 0.f, 0.f, 0.f, 0.f, 0.f, 0.f, 0.f, 0.f, 0.f, 0.f};
#pragma unroll 1
    for (int bi = 0; bi < 8; ++bi) {
        const int trow = 128 * ((n >> 2) & 1) + 4 * (n >> 3) + (n & 3);
        const bf16x8 af0 = *(const LAS bf16x8*)(hT + (trow + 16 * bi) * HT_STRIDE + w * 32 + hh * 16);
        const bf16x8 af1 = *(const LAS bf16x8*)(hT + (trow + 16 * (7 - bi)) * HT_STRIDE + w * 32 + hh * 16);
        f32x16 br[2][2], bm[2][2];
#pragma unroll
        for (int sh = 0; sh < 2; ++sh) { br[0][sh] = __builtin_amdgcn_mfma_f32_32x32x16_bf16(af0, bfr[0][sh], zero16, 0, 0, 0); bm[0][sh] = __builtin_amdgcn_mfma_f32_32x32x16_bf16(af0, bfr[0][2 + sh], zero16, 0, 0, 0);
            br[1][sh] = __builtin_amdgcn_mfma_f32_32x32x16_bf16(af1, bfr[1][sh], zero16, 0, 0, 0); bm[1][sh] = __builtin_amdgcn_mfma_f32_32x32x16_bf16(af1, bfr[1][2 + sh], zero16, 0, 0, 0); }
#pragma unroll
        for (int rr = 0; rr < 16; ++rr)
#pragma unroll
            for (int d = 0; d < 2; ++d)
#pragma unroll
                for (int sh = 0; sh < 2; ++sh) { const int r = d ? 15 - rr : rr;
                    const float t0 = __builtin_fmaf(ar[d][sh], hr[d][sh], __builtin_fmaf(-ai[d][sh], hi[d][sh], br[d][sh][r])), t1 = __builtin_fmaf(ar[d][sh], hi[d][sh], __builtin_fmaf(ai[d][sh], hr[d][sh], bm[d][sh][r])); hr[d][sh] = t0; hi[d][sh] = t1; }
    }
#pragma unroll
    for (int d = 0; d < 2; ++d) { float* So = (float*)(p.ws + WS_S) + ((size_t)(d * 64 + sc) * 64 + g) * 128;
#pragma unroll
        for (int sh = 0; sh < 2; ++sh) *(f32x2*)(So + 2 * (sh * 32 + n)) = (f32x2){hr[d][sh], hi[d][sh]}; }
}

template <bool P2>
__device__ __forceinline__ void phase_s5(const Params& p, const int tid, int j, LAS unsigned char* lds) {
    const int lane = tid & 63, w = __builtin_amdgcn_readfirstlane(tid >> 6);
    LAS unsigned char* hT = lds; LAS unsigned char* hb = lds + HT_BYTES + w * HB_BYTES;
    const bf16_t* H = (const bf16_t*)(p.ws + WS_H); bf16_t* Y = (bf16_t*)(p.ws + WS_Y);
    for (int item = blockIdx.x; item < 256; item += gridDim.x) {
        const int T = item >> 3, gb = item & 7, g = gb * 8 + w;
        __syncthreads();
        for (int q = tid; q < 4096; q += NTHREADS) { const int r = q >> 4, c16 = q & 15;
            *(LAS u32x4*)(hT + r * HT_STRIDE + c16 * 16) = *(const u32x4*)(H + (size_t)(T * 256 + r) * D + gb * 128 + c16 * 8); }
        __syncthreads();
        f32x4 yacc[16];
#pragma unroll
        for (int i = 0; i < 16; ++i) yacc[i] = (f32x4){0.f, 0.f, 0.f, 0.f};
        if constexpr (P2) { s5_dir<P2, 0>(p, j, T, g, w, lane, hT, hb, yacc); s5_dir<P2, 1>(p, j, T, g, w, lane, hT, hb, yacc); }
        else s5_pass1_item(p, j, T, g, w, lane, hT);
        if constexpr (P2) {
            const int ch4 = 4 * (lane >> 4); const f32x4 dsk = *(const f32x4*)(p.ssm_d + j * 1024 + g * 16 + ch4);
#pragma unroll
            for (int tb = 0; tb < 16; ++tb) { LAS u32x2* ptr = (LAS u32x2*)(hT + (16 * tb + (lane & 15)) * HT_STRIDE + w * 32 + ch4 * 2); const u32x2 hv = *ptr;
                const float v0 = yacc[tb][0] + dsk[0] * bf_lo(hv.x), v1 = yacc[tb][1] + dsk[1] * bf_hi(hv.x), v2 = yacc[tb][2] + dsk[2] * bf_lo(hv.y), v3 = yacc[tb][3] + dsk[3] * bf_hi(hv.y);
                u32x2 o; o.x = cvt_pk_bf16(gelu_tanh(v0), gelu_tanh(v1)); o.y = cvt_pk_bf16(gelu_tanh(v2), gelu_tanh(v3)); *ptr = o; }
            __syncthreads();
            for (int q = tid; q < 4096; q += NTHREADS) { const int r = q >> 4, c16 = q & 15;
                *(u32x4*)(Y + (size_t)(T * 256 + r) * D + gb * 128 + c16 * 8) = *(const LAS u32x4*)(hT + r * HT_STRIDE + c16 * 16); }
        }
    }
    __syncthreads();
}

__device__ __forceinline__ void phase_conv(const Params& p, const int tid, int i) {
    const bf16_t* U = (const bf16_t*)(p.ws + WS_UP); bf16_t* A = (bf16_t*)(p.ws + WS_ACT);
    const float* cw = p.conv_w + (size_t)i * 3 * NUP; const float* cb = p.conv_b + (size_t)i * NUP;
    const int NT = gridDim.x * NTHREADS;
    for (int q = blockIdx.x * NTHREADS + tid; q < NTOK * (DFF / 8); q += NT) {
        const int m = q / (DFF / 8), c8 = (q % (DFF / 8)) * 8;
        const int rl = m < 4096 ? 256 : 64; const int pos = m & (rl - 1);
        const int colg = 256 * (c8 >> 7) + (c8 & 127);
        float res[8];
#pragma unroll
        for (int half = 0; half < 2; ++half) {
            const bf16_t* up = U + (size_t)m * NUP + colg + half * 128; const int wc0 = half * DFF + c8;
            u32x4 cur = *(const u32x4*)up, prv = (u32x4){0u, 0u, 0u, 0u}, nxt = (u32x4){0u, 0u, 0u, 0u};
            if (pos > 0) prv = *(const u32x4*)(up - NUP);
            if (pos < rl - 1) nxt = *(const u32x4*)(up + NUP);
            float vals[8];
#pragma unroll
            for (int e = 0; e < 4; ++e) {
                const int c = wc0 + 2 * e;
                vals[2 * e] = cw[c] * bf_lo(prv[e]) + cw[NUP + c] * bf_lo(cur[e]) + cw[2 * NUP + c] * bf_lo(nxt[e]) + cb[c];
                vals[2 * e + 1] = cw[c + 1] * bf_hi(prv[e]) + cw[NUP + c + 1] * bf_hi(cur[e]) + cw[2 * NUP + c + 1] * bf_hi(nxt[e]) + cb[c + 1];
            }
#pragma unroll
            for (int e = 0; e < 8; ++e) res[e] = half == 0 ? vals[e] * sigmoidf_(vals[e]) : res[e] * vals[e];
        }
        u32x4 o; o.x = cvt_pk_bf16(res[0], res[1]); o.y = cvt_pk_bf16(res[2], res[3]); o.z = cvt_pk_bf16(res[4], res[5]); o.w = cvt_pk_bf16(res[6], res[7]);
        *(u32x4*)(A + (size_t)m * DFF + c8) = o;
    }
}

#ifndef TEST_MASK
#define TEST_MASK 0xffff
#endif
#ifndef PROBE_S
#define PROBE_S (-1)
#endif
constexpr int SPL = PPL + ((PROBE_S >= 0 && PROBE_S < 100) ? 1 : 0);
constexpr int NSTEP = 2 + SPL * DEPTH + (PROBE_S == 100 ? 1 : 0);
__global__ void __launch_bounds__(NTHREADS, 2) fwd_kernel(const Params p_in) {
    extern __shared__ __attribute__((aligned(16))) unsigned char lds_raw[];
    LAS unsigned char* lds = (LAS unsigned char*)lds_raw;
    cg::grid_group grid = cg::this_grid();
    const int G = gridDim.x;
    const int wid0 = __builtin_amdgcn_readfirstlane((int)(threadIdx.x >> 6));
    { const int t = wid0 * 64 + (int)__builtin_amdgcn_mbcnt_hi(~0u, __builtin_amdgcn_mbcnt_lo(~0u, 0u));
      if (t < 16) ((LAS unsigned*)(lds + MISC_OFF))[t] = 0u;
      __syncthreads();
      (void)xcd_barrier_post((unsigned*)(p_in.ws + WS_CTL), (volatile LAS unsigned*)(lds + MISC_OFF), t == 0); }
    for (int ph_ = p_in.ph_lo; ph_ < p_in.ph_hi; ++ph_) {
        const int ph = (PROBE_S == 100) ? (ph_ > 0 ? ph_ - 1 : 0) : ph_;
#if defined(__HIP_DEVICE_COMPILE__)
        const __attribute__((address_space(4))) Params* kq = (const __attribute__((address_space(4))) Params*)__builtin_amdgcn_kernarg_segment_ptr();
        asm volatile("" : "+s"(kq));
        Params p = *kq;
#else
        Params p = p_in;
#endif
        int cb = blockIdx.x, zl = 0;
        asm volatile("" : "+s"(p.ws), "+s"(cb), "+v"(zl));
        const int tid = wid0 * 64 + (int)__builtin_amdgcn_mbcnt_hi(~0u, __builtin_amdgcn_mbcnt_lo(~0u, (unsigned)zl));
        unsigned char* ws = p.ws;
        const float* mod = (const float*)(ws + WS_MOD);
        if (ph == 0) { if (TEST_MASK & 4) phase_prep(p, tid, lds); }
        else if (ph_ == NSTEP - 1) {
            phase_norm<1>(p, tid, false, false, nullptr, nullptr, p.g_final, nullptr, nullptr);
        } else {
            const int i = (ph - 1) / SPL, s0 = (ph - 1) % SPL, s = (PROBE_S >= 0 && PROBE_S < 100 && s0 > PROBE_S) ? s0 - 1 : s0, j = i >> 1; const bool is_s5 = (i & 1) == 0;
            const float* modi = mod + (size_t)i * 3 * 6144;
#if defined(PROBE_PAR)
            if (PROBE_S >= 0 && PROBE_S < 100 && s0 == PROBE_S + 1 && (i & 1) != PROBE_PAR) goto seam;
#endif
            if (s == 0) {
                const float* modp = mod + (size_t)(i > 0 ? i - 1 : 0) * 3 * 6144;
                const bool rep_ = (PROBE_S == 0 && s0 == 1);
                phase_norm<0>(p, tid, i == 0 && !rep_, false, modp + 5120, nullptr, p.g_mix + i * D, modi + 1024, modi);
            } else if (s == 1) {
                if (is_s5) { if (TEST_MASK & 1) phase_s5<false>(p, tid, j, lds); }
                else { SchedChan S{(const char*)(ws + WS_DFTC), (const char*)(ws + WS_H), G, cb}; EpiChan E{(bf16_t*)(ws + WS_ZT)};
                    if (TEST_MASK & 8) pg8::gemm_phase<EpiChan, SchedChan, true, true>(tid, lds, 256, 1024, S, E); }
            } else if (s == 2) {
                if (is_s5) { if (TEST_MASK & 2) phase_s5<true>(p, tid, j, lds); }
                else { SchedSeqH S{(const char*)(ws + WS_AL256), (const char*)(ws + WS_AL2048), (const char*)(ws + WS_ZT), G, cb}; EpiSeqH E{(bf16_t*)(ws + WS_Y)};
                    if (TEST_MASK & 16) pg8::gemm_phase<EpiSeqH, SchedSeqH, true, true, true>(tid, lds, 4096, 4096, S, E); }
            } else if (s == 3) {
                if (is_s5) { SchedStd S{(const char*)(ws + WS_Y), (const char*)(ws + WS_WGLU) + (size_t)j * 2048 * 1024 * 2, 32, 8, 1, 1024, 1024, 16, G, cb, 256};
                    EpiGlu E{(float*)(ws + WS_X), p.b_glu + j * 2048, modi + 2048};
                    if (TEST_MASK & 32) pg8::gemm_phase<EpiGlu, SchedStd, true, true>(tid, lds, 1024, 1024, S, E); }
                else { SchedStd S{(const char*)(ws + WS_Y), (const char*)(ws + WS_WF) + (size_t)j * 1024 * 1024 * 2, 32, 8, 1, 1024, 1024, 16, G, cb, 128};
                    EpiResidH E{(float*)(ws + WS_X), modi + 2048, p.b_fourier + j * D};
                    if (TEST_MASK & 64) pg8::gemm_phase<EpiResidH, SchedStd, true, true, true>(tid, lds, 1024, 1024, S, E); }
            } else if (s == 4) {
                const bool rep_ = (PROBE_S == 4 && s0 == 5);
                phase_norm<0>(p, tid, false, false, modi + 2048, p.b_fourier + j * D, p.g_ffn + i * D, modi + 4096, modi + 3072);
            } else if (s == 5) {
                SchedStd S{(const char*)(ws + WS_H), (const char*)(ws + WS_WUP) + (size_t)i * NUP * 1024 * 2, 32, 22, 1, 1024, 1024, 16, G, cb, 256};
                EpiUpConv E{(bf16_t*)(ws + WS_ACT), p.conv_w + (size_t)i * 3 * NUP, p.conv_b + (size_t)i * NUP, lds + pg8::STAGE_BYTES};
                if (TEST_MASK & 128) pg8::gemm_phase<EpiUpConv, SchedStd, true, true>(tid, lds, 1024, 1024, S, E);
                if (i + 1 < DEPTH) {
                    const int nfull = 704 % G, nidle = nfull ? G - nfull : G, first = nfull ? nfull : 0;
                    if (cb >= first) { const int wv = __builtin_amdgcn_readfirstlane(tid >> 6); LAS float* scr = (LAS float*)(lds + wv * 8704);
                        for (int it = (cb - first) * 8 + wv; it < I_UP + I_DN; it += nidle * 8) convert_updown_item(p, i + 1, it, scr, tid & 63); }
                }
            } else {
                SchedStd S{(const char*)(ws + WS_ACT), (const char*)(ws + WS_WDN) + (size_t)i * 1024 * DFF * 2, 32, 8, 1, DFF, DFF, 44, G, cb, 128};
                EpiResidH E{(float*)(ws + WS_X), modi + 5120, nullptr};
                if (TEST_MASK & 256) pg8::gemm_phase<EpiResidH, SchedStd, true, true, true>(tid, lds, DFF, DFF, S, E);
            }
        }
#if defined(PROBE_PAR)
        seam:
#endif
        if (ph_ + 1 < p_in.ph_hi) { if (p_in.ph_hi < 0) grid.sync(); else { XcdBarrier xbar; xbar.bar = (unsigned*)(p_in.ws + WS_CTL); xbar.x = xb_xcc_id(); xbar.st = (volatile LAS unsigned*)(lds + MISC_OFF); xcd_barrier(xbar, tid == 0); } }
    }
}

#ifndef N_LAUNCH_MODE
#define N_LAUNCH_MODE 1
#endif
extern "C" void kernel_launch(void* const* d_in, const int* in_sizes, int n_in, void* d_out, int out_size, void* d_ws, size_t ws_size, hipStream_t stream) {
    static int grid = 0;
    if (grid == 0) {
        if (n_in != 27 || ws_size < WS_END) { fprintf(stderr, "kernel_launch: unexpected inputs (n_in %d, ws %zu)\n", n_in, ws_size); grid = -1; return; }
        int dev = 0, cus = 0, per_cu = 0;
        hipGetDevice(&dev); hipDeviceGetAttribute(&cus, hipDeviceAttributeMultiprocessorCount, dev);
        if (hipFuncSetAttribute((const void*)fwd_kernel, hipFuncAttributeMaxDynamicSharedMemorySize, LDS_BYTES) != hipSuccess) { fprintf(stderr, "kernel_launch: hipFuncSetAttribute failed\n"); grid = -1; return; }
        if (hipOccupancyMaxActiveBlocksPerMultiprocessor(&per_cu, (const void*)fwd_kernel, NTHREADS, LDS_BYTES) != hipSuccess || per_cu < 1) { fprintf(stderr, "kernel_launch: occupancy query says %d\n", per_cu); per_cu = 1; }
        (void)hipGetLastError();
        grid = cus * per_cu;
        if (grid > 256) grid = 256;
    }
    if (grid < 0) return;
    Params p{};
    const float** f = (const float**)&p;
    for (int i = 0; i < 27; ++i) f[i] = (const float*)d_in[i];
    p.out = (float*)d_out; p.ws = (unsigned char*)d_ws;
#if N_LAUNCH_MODE == 1
    (void)hipMemsetAsync((char*)d_ws + WS_CTL, 0, CTL_BYTES, stream);
    p.ph_lo = 0; p.ph_hi = NSTEP;
    void* args[] = {&p};
    hipError_t e = hipLaunchCooperativeKernel((const void*)fwd_kernel, dim3(grid), dim3(NTHREADS), args, LDS_BYTES, stream);
    if (e != hipSuccess) fprintf(stderr, "cooperative launch failed: %s (grid %d)\n", hipGetErrorString(e), grid);
#else
    for (int ph = 0; ph < NSTEP; ++ph) { p.ph_lo = ph; p.ph_hi = ph + 1; hipLaunchKernelGGL(fwd_kernel, dim3(grid), dim3(NTHREADS), LDS_BYTES, stream, p); }
#endif
}
```
